# Optimizing an MI355X kernel written in HIP

```python
import math
import jax, jax.numpy as jnp
from jax import lax
import numpy as np

D_MODEL = 2048
BATCH = 4
SEQ = 2048
DEPTH = 2

N_MIXERS = 2
CHUNK = 128
A_WIDTH = D_MODEL
A_GROUPS = 8
A_HEAD = A_WIDTH // A_GROUPS
B_WIDTH = D_MODEL
B_WINDOWS = (2, 4, 8, 16)
B_GROUPS = len(B_WINDOWS)
B_HEAD = B_WIDTH // B_GROUPS
D_FF = 4 * D_MODEL
N_A = (DEPTH + 1) // 2
N_B = DEPTH // 2
EPS = 1e-6

kernel_name = "hybrid_chunked_gmlp_multiscale_pool"


def rmsnorm(x, g):
    x32 = x.astype(jnp.float32)
    y = x32 * lax.rsqrt(jnp.mean(x32 * x32, axis=-1, keepdims=True) + EPS)
    return (y * g.astype(jnp.float32)).astype(x.dtype)


def layernorm(x, g, b):
    x32 = x.astype(jnp.float32)
    mu = jnp.mean(x32, axis=-1, keepdims=True)
    xc = x32 - mu
    y = xc * lax.rsqrt(jnp.mean(xc * xc, axis=-1, keepdims=True) + EPS)
    return (y * g.astype(jnp.float32) + b.astype(jnp.float32)).astype(x.dtype)


def chunked_gmlp_mixer(h, w_in, ln_g, ln_b, w_s, b_s, w_out):
    bsz, seq, _ = h.shape
    n_chunks = seq // CHUNK
    z = jax.nn.gelu(h @ w_in, approximate=False)
    u, v = jnp.split(z, 2, axis=-1)
    v = layernorm(v, ln_g, ln_b)
    v = v.reshape(bsz, n_chunks, CHUNK, A_GROUPS, A_HEAD)
    causal = jnp.tril(jnp.ones((CHUNK, CHUNK), dtype=w_s.dtype))
    w_masked = w_s * causal[None]
    s = jnp.einsum('gts,bcsgd->bctgd', w_masked, v) + jnp.transpose(b_s)[None, None, :, :, None]
    gated = u * s.reshape(bsz, seq, A_WIDTH)
    return gated @ w_out


def causal_window_mean(v, w):
    seq = v.shape[1]
    v32 = v.astype(jnp.float32)
    c = jnp.cumsum(v32, axis=1)
    c_prev = jnp.pad(c, ((0, 0), (w, 0), (0, 0)))[:, :seq]
    count = jnp.minimum(jnp.arange(1, seq + 1), w).astype(jnp.float32)
    return ((c - c_prev) / count[None, :, None]).astype(v.dtype)


def multiscale_pool_mixer(h, w_in, w_grp, scale, w_out):
    bsz, seq, _ = h.shape
    v = (h @ w_in).reshape(bsz, seq, B_GROUPS, B_HEAD)
    pooled = jnp.stack(
        [causal_window_mean(v[:, :, g], w) - v[:, :, g] for g, w in enumerate(B_WINDOWS)],
        axis=2)
    mixed = jnp.einsum('bsgc,gcd->bsgd', pooled, w_grp).reshape(bsz, seq, B_WIDTH)
    return (mixed * scale) @ w_out


def sqrelu_mlp(h, w1, w2):
    a = jax.nn.relu(h @ w1)
    return (a * a) @ w2


def setup_inputs(seed: int = 0) -> dict:
    key = jax.random.key(seed)
    ks = jax.random.split(key, 20)
    f32 = jnp.float32

    def nrm(k, shape, scale):
        return jax.random.normal(k, shape, f32) * scale

    x = jax.random.normal(ks[0], (BATCH, SEQ, D_MODEL), f32)
    a_w_in = nrm(ks[1], (N_A, D_MODEL, 2 * A_WIDTH), D_MODEL ** -0.5)
    a_ln_g = 1.0 + nrm(ks[2], (N_A, A_WIDTH), 0.02)
    a_ln_b = nrm(ks[3], (N_A, A_WIDTH), 0.02)
    a_w_s = nrm(ks[4], (N_A, A_GROUPS, CHUNK, CHUNK), 0.5 * CHUNK ** -0.5)
    a_b_s = 1.0 + nrm(ks[5], (N_A, A_GROUPS, CHUNK), 0.02)
    a_w_out = nrm(ks[6], (N_A, A_WIDTH, D_MODEL), A_WIDTH ** -0.5)
    b_w_in = nrm(ks[7], (N_B, D_MODEL, B_WIDTH), D_MODEL ** -0.5)
    b_w_grp = nrm(ks[8], (N_B, B_GROUPS, B_HEAD, B_HEAD), B_HEAD ** -0.5)
    b_scale = 0.5 + nrm(ks[9], (N_B, B_WIDTH), 0.02)
    b_w_out = nrm(ks[10], (N_B, B_WIDTH, D_MODEL), B_WIDTH ** -0.5)
    norm_mix = 1.0 + nrm(ks[11], (DEPTH, D_MODEL), 0.02)
    norm_mlp = 1.0 + nrm(ks[12], (DEPTH, D_MODEL), 0.02)
    mlp_w1 = nrm(ks[13], (DEPTH, D_MODEL, D_FF), D_MODEL ** -0.5)
    mlp_w2 = nrm(ks[14], (DEPTH, D_FF, D_MODEL), D_FF ** -0.5)
    final_norm = 1.0 + nrm(ks[15], (D_MODEL,), 0.02)
    return {"x": x,
            "a_w_in": a_w_in, "a_ln_g": a_ln_g, "a_ln_b": a_ln_b, "a_w_s": a_w_s,
            "a_b_s": a_b_s, "a_w_out": a_w_out,
            "b_w_in": b_w_in, "b_w_grp": b_w_grp, "b_scale": b_scale, "b_w_out": b_w_out,
            "norm_mix": norm_mix, "norm_mlp": norm_mlp, "mlp_w1": mlp_w1, "mlp_w2": mlp_w2,
            "final_norm": final_norm}


def reference(x, a_w_in, a_ln_g, a_ln_b, a_w_s, a_b_s, a_w_out,
              b_w_in, b_w_grp, b_scale, b_w_out,
              norm_mix, norm_mlp, mlp_w1, mlp_w2, final_norm):
    h = x
    for i in range(DEPTH):
        hn = rmsnorm(h, norm_mix[i])
        if i % N_MIXERS == 0:
            j = i // N_MIXERS
            mix = chunked_gmlp_mixer(hn, a_w_in[j], a_ln_g[j], a_ln_b[j],
                                     a_w_s[j], a_b_s[j], a_w_out[j])
        else:
            j = i // N_MIXERS
            mix = multiscale_pool_mixer(hn, b_w_in[j], b_w_grp[j], b_scale[j], b_w_out[j])
        h = h + mix
        h = h + sqrelu_mlp(rmsnorm(h, norm_mlp[i]), mlp_w1[i], mlp_w2[i])
    return rmsnorm(h, final_norm)
```

```cpp
#include <hip/hip_runtime.h>
#include <hip/hip_cooperative_groups.h>
#include <cstdio>
#include <cstdint>
namespace cg = cooperative_groups;

#define LAS __attribute__((address_space(3)))
typedef unsigned short bf16_t;
typedef short bf16x8 __attribute__((ext_vector_type(8)));
typedef float f32x4 __attribute__((ext_vector_type(4)));
typedef float f32x2 __attribute__((ext_vector_type(2)));
typedef unsigned u32x4 __attribute__((ext_vector_type(4)));
typedef unsigned u32x2 __attribute__((ext_vector_type(2)));

constexpr int MTOK = 8192, DM = 2048, FF = 8192, SEQ = 2048;
constexpr float EPS = 1e-6f;
constexpr int BM = 256, BK = 64, HALF = 128, HTB = HALF * BK * 2, STAGE_BYTES = 8 * HTB, NXCD = 8, WGM = 8;
constexpr int RS_OFF = STAGE_BYTES;
constexpr int XB_ST_OFF = STAGE_BYTES + 2048;
constexpr int LDS_BYTES = STAGE_BYTES + 2048 + 16;

#ifndef DUP_PHASE
#define DUP_PHASE -1
#endif
#define REP(k) ((DUP_PHASE == (k)) ? 2 : 1)
#ifndef FUSE_FINAL
#define FUSE_FINAL 1
#endif
#ifndef N_LAUNCH_MODE
#define N_LAUNCH_MODE 1
#endif

constexpr size_t WS_WT_AIN = 0;
constexpr size_t WS_WT_AOUT = WS_WT_AIN + (size_t)4096 * 2048 * 2;
constexpr size_t WS_WT_W1_0 = WS_WT_AOUT + (size_t)2048 * 2048 * 2;
constexpr size_t WS_WT_W2_0 = WS_WT_W1_0 + (size_t)8192 * 2048 * 2;
constexpr size_t WS_WT_BIN = WS_WT_W2_0 + (size_t)8192 * 2048 * 2;
constexpr size_t WS_WT_GRP = WS_WT_BIN + (size_t)2048 * 2048 * 2;
constexpr size_t WS_WT_BOUT = WS_WT_GRP + (size_t)2048 * 512 * 2;
constexpr size_t WS_WT_W1_1 = WS_WT_BOUT + (size_t)2048 * 2048 * 2;
constexpr size_t WS_WT_W2_1 = WS_WT_W1_1 + (size_t)8192 * 2048 * 2;
constexpr size_t WS_HB = WS_WT_W2_1 + (size_t)8192 * 2048 * 2;
constexpr size_t WS_ACT = WS_HB + (size_t)MTOK * DM * 2;
constexpr size_t WS_XST = WS_ACT + (size_t)MTOK * FF * 2;
constexpr size_t WS_HST1 = WS_XST + (size_t)MTOK * 32 * 4;
constexpr size_t WS_HST2 = WS_HST1 + (size_t)MTOK * 32 * 4;
constexpr size_t WS_HST3 = WS_HST2 + (size_t)MTOK * 32 * 4;
constexpr size_t WS_HST4 = WS_HST3 + (size_t)MTOK * 32 * 4;
constexpr size_t WS_VST = WS_HST4 + (size_t)MTOK * 32 * 4;
constexpr size_t WS_BAR = WS_VST + (size_t)MTOK * 32 * 8;
constexpr size_t WS_WCT = WS_BAR + 32768;
constexpr size_t WS_END = WS_WCT + (size_t)2048 * 2048 * 2;

struct Args {
    const float* x; const float* a_w_in; const float* a_ln_g; const float* a_ln_b; const float* a_w_s; const float* a_b_s; const float* a_w_out;
    const float* b_w_in; const float* b_w_grp; const float* b_scale; const float* b_w_out;
    const float* norm_mix; const float* norm_mlp; const float* mlp_w1; const float* mlp_w2; const float* final_norm;
    float* out; unsigned char* ws; int ph_lo, ph_hi;
};

__device__ __forceinline__ unsigned cvt_pk_bf16(float lo, float hi) { unsigned r; asm volatile("v_cvt_pk_bf16_f32 %0, %1, %2" : "=v"(r) : "v"(lo), "v"(hi)); return r; }
__device__ __forceinline__ float bf_lo(unsigned w) { return __uint_as_float(w << 16); }
__device__ __forceinline__ float bf_hi(unsigned w) { return __uint_as_float(w & 0xffff0000u); }
__device__ __forceinline__ float wave_sum(float v) {
#pragma unroll
    for (int o = 1; o < 64; o <<= 1) v += __shfl_xor(v, o);
    return v;
}
#define LDS_WAIT() asm volatile("s_waitcnt lgkmcnt(0)" ::: "memory")

__device__ __forceinline__ f32x2 gelu_pk(f32x2 v) {
    const f32x2 av = __builtin_elementwise_abs(v), d = av * 0.2316418882f + 1.0f;
    f32x2 t; t.x = __builtin_amdgcn_rcpf(d.x); t.y = __builtin_amdgcn_rcpf(d.y);
    f32x2 q = t * 0.5307027145f + (-0.7265760135f); q = q * t + 0.7107068705f; q = q * t + (-0.142248368f); q = q * t + 0.127414796f; q = q * t;
    const f32x2 s = (v * v) * (-0.72134752044f);
    f32x2 e; e.x = __builtin_amdgcn_exp2f(s.x); e.y = __builtin_amdgcn_exp2f(s.y);
    const f32x2 m = v * (q * e), r = v - m;
    f32x2 o; o.x = v.x < 0.f ? m.x : r.x; o.y = v.y < 0.f ? m.y : r.y; return o;
}

__host__ __device__ __forceinline__ int lds_byte(int r, int c) { const int st = (r >> 4) * 2 + (c >> 5), rr = r & 15, cc = c & 31, ob = rr * 64 + cc * 2; return st * 1024 + (ob ^ (((ob >> 9) & 1) << 5)); }
__host__ __device__ __forceinline__ void stage_rc(int b, int& R, int& C) { const int st = b / 1024, sb = b % 1024, swz = sb ^ (((sb >> 9) & 1) << 5); R = (st >> 1) * 16 + swz / 64; C = (st & 1) * 32 + (swz % 64) / 2; }
__host__ __device__ __forceinline__ int perm32(int rho) { const int n = rho >> 4, i = rho & 15; return 8 * (i >> 2) + 4 * n + (i & 3); }

struct Unit { int pm, pn; };
struct StaticOrder {
    int nM, nN, nwg, G, c;
    __device__ void init(int M, int N, int G_, int c_) { nM = M / BM; nN = N / BM; nwg = nM * nN; G = G_; c = c_; }
    __device__ bool next(int i, Unit& u) const {
        const long L = (long)i * G + c; if (L >= nwg) return false;
        int wgid = (int)L; { const int q = nwg / NXCD, r = nwg % NXCD, xcd = wgid % NXCD, off = wgid / NXCD; wgid = (xcd < r ? xcd * (q + 1) : r * (q + 1) + (xcd - r) * q) + off; }
        const int nig = WGM * nN, gid = wgid / nig, fm = gid * WGM, gsz = (nM - fm) < WGM ? (nM - fm) : WGM;
        u.pm = fm + ((wgid % nig) % gsz); u.pn = (wgid % nig) / gsz; return true;
    }
};
struct Epi { int mode; bf16_t* ob; int ldob; float* of; const float* res; float* st_out; const float* st_in; unsigned* cnt; const float* gain; const bf16_t* resb; };

template <int MODE>
__device__ __forceinline__ void epi_prep(const Epi& E, const Unit& u, LAS float* rs) {
    if (MODE == 0 || MODE == 2 || MODE == 3) {
        const int tid = threadIdx.x, row = tid >> 1, half = tid & 1;
        const f32x4* p = (const f32x4*)(E.st_in + ((size_t)(u.pm * BM + row) * 32 + half * 16));
        const f32x4 a = p[0], b = p[1], c = p[2], d = p[3];
        float s = ((a.x + a.y) + (a.z + a.w)) + ((b.x + b.y) + (b.z + b.w)) + ((c.x + c.y) + (c.z + c.w)) + ((d.x + d.y) + (d.z + d.w));
        s += __shfl_xor(s, 1);
        if (!half) rs[row] = __builtin_amdgcn_rsqf(s * (1.0f / DM) + EPS);
    }
}

template <int MODE>
__device__ __forceinline__ void epi_run(const Epi& E, const f32x4 (&acc)[2][2][4][2], const Unit& u, int wr, int wc, int fr, int fq, const LAS float* rs) {
    const int rl0 = wr * 64 + fr, col0 = u.pn * BM + wc * 32 + 8 * fq;
    constexpr int mode = MODE;
    if (mode == 5) {
        const int lane = fr + 16 * fq;
        unsigned* cw = E.cnt + u.pm * 64;
#pragma unroll
        for (int ai = 0; ai < 2; ++ai)
#pragma unroll
            for (int m = 0; m < 4; ++m) {
                const size_t row = (size_t)(u.pm * BM + rl0 + ai * HALF + m * 16);
                float ss = 0.f;
#pragma unroll
                for (int bj = 0; bj < 2; ++bj) { const f32x4 v0 = acc[ai][bj][m][0], v1 = acc[ai][bj][m][1];
                    ss += (v0.x * v0.x + v0.y * v0.y) + (v0.z * v0.z + v0.w * v0.w) + (v1.x * v1.x + v1.y * v1.y) + (v1.z * v1.z + v1.w * v1.w); }
                ss += __shfl_xor(ss, 16); ss += __shfl_xor(ss, 32);
                if (fq == 0) __hip_atomic_store((unsigned*)(E.st_out + row * 32 + u.pn * 4 + wc), __float_as_uint(ss), __ATOMIC_RELAXED, __HIP_MEMORY_SCOPE_AGENT);
            }
        asm volatile("s_waitcnt vmcnt(0)" ::: "memory");
        if (lane == 0) (void)__hip_atomic_fetch_add(cw, 1u, __ATOMIC_RELAXED, __HIP_MEMORY_SCOPE_AGENT);
        { unsigned sp = 0;
          while ((unsigned)__builtin_amdgcn_readfirstlane(__hip_atomic_load(cw, __ATOMIC_RELAXED, __HIP_MEMORY_SCOPE_AGENT)) < 64u) { __builtin_amdgcn_s_sleep(2); if (++sp > (1u << 22)) break; } }
        __builtin_amdgcn_fence(__ATOMIC_ACQUIRE, "agent");
        asm volatile("s_waitcnt vmcnt(0)" ::: "memory");
        f32x4 gv[2][2];
#pragma unroll
        for (int bj = 0; bj < 2; ++bj) { gv[bj][0] = *(const f32x4*)(E.gain + col0 + bj * HALF); gv[bj][1] = *(const f32x4*)(E.gain + col0 + bj * HALF + 4); }
#pragma unroll
        for (int ai = 0; ai < 2; ++ai)
#pragma unroll
            for (int m = 0; m < 4; ++m) {
                const size_t row = (size_t)(u.pm * BM + rl0 + ai * HALF + m * 16);
                const f32x4* pp = (const f32x4*)(E.st_out + row * 32 + 8 * fq);
                const f32x4 pa = pp[0], pb = pp[1];
                float s = ((pa.x + pa.y) + (pa.z + pa.w)) + ((pb.x + pb.y) + (pb.z + pb.w));
                s += __shfl_xor(s, 16); s += __shfl_xor(s, 32);
                const float r = __builtin_amdgcn_rsqf(s * (1.0f / DM) + EPS);
                float* op = E.of + row * DM + col0;
#pragma unroll
                for (int bj = 0; bj < 2; ++bj) { *(f32x4*)(op + bj * HALF) = acc[ai][bj][m][0] * r * gv[bj][0]; *(f32x4*)(op + bj * HALF + 4) = acc[ai][bj][m][1] * r * gv[bj][1]; }
                asm volatile("" ::: "memory");
            }
    } else if (mode == 1 || mode == 6) {
#pragma unroll
        for (int ai = 0; ai < 2; ++ai)
#pragma unroll
            for (int m = 0; m < 4; ++m) {
                const size_t row = (size_t)(u.pm * BM + rl0 + ai * HALF + m * 16);
                float ss = 0.f;
#pragma unroll
                for (int bj = 0; bj < 2; ++bj) {
                    const f32x4 v0 = acc[ai][bj][m][0], v1 = acc[ai][bj][m][1];
                    ss += (v0.x * v0.x + v0.y * v0.y) + (v0.z * v0.z + v0.w * v0.w) + (v1.x * v1.x + v1.y * v1.y) + (v1.z * v1.z + v1.w * v1.w);
                    u32x4 w; w.x = cvt_pk_bf16(v0.x, v0.y); w.y = cvt_pk_bf16(v0.z, v0.w); w.z = cvt_pk_bf16(v1.x, v1.y); w.w = cvt_pk_bf16(v1.z, v1.w);
                    *(u32x4*)(E.ob + row * E.ldob + col0 + bj * HALF) = w;
                }
                ss += __shfl_xor(ss, 16); ss += __shfl_xor(ss, 32);
                if (fq == 0) E.st_out[row * 32 + u.pn * 4 + wc] = ss;
                asm volatile("" ::: "memory");
            }
    } else {
        const bool vstat = (mode == 0) && (u.pn >= 8);
#pragma unroll
        for (int ai = 0; ai < 2; ++ai)
#pragma unroll
            for (int m = 0; m < 4; ++m) {
                const int rl = rl0 + ai * HALF + m * 16;
                const size_t row = (size_t)(u.pm * BM + rl);
                const float r = (mode == 4) ? 1.0f : rs[rl];
                float s1 = 0.f, s2 = 0.f;
#pragma unroll
                for (int bj = 0; bj < 2; ++bj) {
                    f32x4 v0 = acc[ai][bj][m][0] * r, v1 = acc[ai][bj][m][1] * r;
                    if (mode == 0) {
                        const f32x2 a = gelu_pk((f32x2){v0.x, v0.y}), b = gelu_pk((f32x2){v0.z, v0.w}), c = gelu_pk((f32x2){v1.x, v1.y}), d = gelu_pk((f32x2){v1.z, v1.w});
                        v0 = (f32x4){a.x, a.y, b.x, b.y}; v1 = (f32x4){c.x, c.y, d.x, d.y};
                        s1 += ((v0.x + v0.y) + (v0.z + v0.w)) + ((v1.x + v1.y) + (v1.z + v1.w));
                        s2 += (v0.x * v0.x + v0.y * v0.y) + (v0.z * v0.z + v0.w * v0.w) + (v1.x * v1.x + v1.y * v1.y) + (v1.z * v1.z + v1.w * v1.w);
                    } else if (mode == 2) {
                        v0 = __builtin_elementwise_max(v0, (f32x4){0.f, 0.f, 0.f, 0.f}); v1 = __builtin_elementwise_max(v1, (f32x4){0.f, 0.f, 0.f, 0.f});
                        v0 = v0 * v0; v1 = v1 * v1;
                    }
                    u32x4 w; w.x = cvt_pk_bf16(v0.x, v0.y); w.y = cvt_pk_bf16(v0.z, v0.w); w.z = cvt_pk_bf16(v1.x, v1.y); w.w = cvt_pk_bf16(v1.z, v1.w);
                    *(u32x4*)(E.ob + row * E.ldob + col0 + bj * HALF) = w;
                }
                if (vstat) {
                    s1 += __shfl_xor(s1, 16); s1 += __shfl_xor(s1, 32); s2 += __shfl_xor(s2, 16); s2 += __shfl_xor(s2, 32);
                    if (fq == 0) *(f32x2*)(E.st_out + (row * 32 + (u.pn - 8) * 4 + wc) * 2) = (f32x2){s1, s2};
                }
                asm volatile("" ::: "memory");
            }
    }
}

template <int MODE, int N, int K, int LDA, bool GROUPED, int M = MTOK>
__device__ __forceinline__ void gemm_phase(LAS unsigned char* lds, const bf16_t* gA, const bf16_t* gBt, const Epi& E, int G, int c) {
    const int tid = threadIdx.x, wid = __builtin_amdgcn_readfirstlane(tid >> 6), lane = tid & 63, wr = wid >> 2, wc = wid & 3, fr = lane & 15, fq = lane >> 4;
    constexpr int nt = K / BK, lda = LDA;
    constexpr bool RELAX = false;
    StaticOrder S; S.init(M, N, G, c);
    LAS float* rsl = (LAS float*)(lds + RS_OFF);
    unsigned voffA[2], voffB[2];
#pragma unroll
    for (int i = 0; i < 2; ++i) { int R, C; stage_rc(tid * 16 + i * 8192, R, C); const int Rb = (R & ~31) + perm32(R & 31);
        voffA[i] = (unsigned)(R * lda + C) * 2u; voffB[i] = (unsigned)(Rb * K + C) * 2u; }
    const size_t kstep = (size_t)(BK * 2);
    const size_t hstepA = (size_t)HALF * lda * 2, hstepB = (size_t)HALF * K * 2;
    const size_t tstepA = 2 * hstepA, tstepB = 2 * hstepB;
    const unsigned ldsw = (unsigned)wid * 1024u;
    const int aoff = lds_byte(wr * 64 + fr, fq * 8), boff = lds_byte(wc * 32 + fr, fq * 8);
#define PG8_SA(b, h) (((b) * 2 + (h)) * HTB)
#define PG8_SB(b, h) ((4 + (b) * 2 + (h)) * HTB)
#define PG8_STAGE(bufoff, gbase, voff) do { const char* _g = (const char*)(gbase); asm volatile("" : "+s"(_g)); _Pragma("unroll") for (int _i = 0; _i < 2; ++_i) { unsigned _v = (voff)[_i]; asm volatile("" : "+v"(_v)); \
        __builtin_amdgcn_global_load_lds((const unsigned*)(_g + _v), (LAS unsigned*)(lds + (bufoff) + ldsw + _i * 8192), 16, 0, 0); } } while (0)
#define PG8_LDA(dst, b, h) do { _Pragma("unroll") for (int m = 0; m < 4; ++m) _Pragma("unroll") for (int k = 0; k < 2; ++k) dst[m][k] = *(const LAS bf16x8*)(lds + PG8_SA(b, h) + aoff + m * 2048 + k * 1024); } while (0)
#define PG8_LDB(dst, b, h) do { _Pragma("unroll") for (int n = 0; n < 2; ++n) _Pragma("unroll") for (int k = 0; k < 2; ++k) dst[n][k] = *(const LAS bf16x8*)(lds + PG8_SB(b, h) + boff + n * 2048 + k * 1024); } while (0)
#define PG8_MMA(ai, bj, At, Bt) do { __builtin_amdgcn_s_setprio(1); _Pragma("unroll") for (int m = 0; m < 4; ++m) _Pragma("unroll") for (int n = 0; n < 2; ++n) _Pragma("unroll") for (int k = 0; k < 2; ++k) \
        acc[ai][bj][m][n] = __builtin_amdgcn_mfma_f32_16x16x32_bf16(Bt[n][k], At[m][k], acc[ai][bj][m][n], 0, 0, 0); __builtin_amdgcn_s_setprio(0); } while (0)
#define PG8_WAIT_V(n) asm volatile("s_waitcnt vmcnt(" #n ")" ::: "memory")
#define PG8_WAIT_V8_OR24(flag) asm volatile("s_cmp_lg_u32 %0, 0\n\ts_cbranch_scc1 1f\n\ts_waitcnt vmcnt(8)\n1:\n\ts_waitcnt vmcnt(24)" :: "s"(flag) : "memory", "scc")
#define PG8_WAIT_L(n) asm volatile("s_waitcnt lgkmcnt(" #n ")" ::: "memory")
#define PG8_BAR __builtin_amdgcn_s_barrier()
#define PG8_SCHED __builtin_amdgcn_sched_barrier(0)
#define UNIT_A(u) ((const char*)gA + (size_t)(u).pm * tstepA + (GROUPED ? (size_t)(((u).pn >> 1) * 512) * 2 : (size_t)0))
    Unit cur, nxt; int ui = 0;
    if (!S.next(0, cur)) return;
    f32x4 acc[2][2][4][2];
#define ACC_INIT(u) do { \
    _Pragma("unroll") for (int a_ = 0; a_ < 2; ++a_) _Pragma("unroll") for (int m_ = 0; m_ < 4; ++m_) { \
        const size_t ro_ = (size_t)((u).pm * BM + wr * 64 + fr + a_ * HALF + m_ * 16) * DM + (u).pn * BM + wc * 32 + 8 * fq; \
        _Pragma("unroll") for (int b_ = 0; b_ < 2; ++b_) { \
            if (MODE == 1) { acc[a_][b_][m_][0] = *(const f32x4*)(E.res + ro_ + b_ * HALF); acc[a_][b_][m_][1] = *(const f32x4*)(E.res + ro_ + b_ * HALF + 4); } \
            else if (MODE == 6 || MODE == 5) { const u32x4 w_ = *(const u32x4*)(E.resb + ro_ + b_ * HALF); \
                acc[a_][b_][m_][0] = (f32x4){bf_lo(w_.x), bf_hi(w_.x), bf_lo(w_.y), bf_hi(w_.y)}; acc[a_][b_][m_][1] = (f32x4){bf_lo(w_.z), bf_hi(w_.z), bf_lo(w_.w), bf_hi(w_.w)}; } \
            else { acc[a_][b_][m_][0] = (f32x4){0.f, 0.f, 0.f, 0.f}; acc[a_][b_][m_][1] = (f32x4){0.f, 0.f, 0.f, 0.f}; } } } } while (0)
    ACC_INIT(cur);
    bf16x8 At[4][2], B0[2][2], B1[2][2];
    const char* cA = UNIT_A(cur); const char* cB = (const char*)gBt + (size_t)cur.pn * tstepB;
    int slot = 0;
    PG8_STAGE(PG8_SB(0, 0), cB, voffB); PG8_STAGE(PG8_SB(0, 1), cB + hstepB, voffB); PG8_STAGE(PG8_SA(0, 0), cA, voffA); PG8_STAGE(PG8_SA(0, 1), cA + hstepA, voffA);
    PG8_STAGE(PG8_SB(1, 0), cB + kstep, voffB); PG8_STAGE(PG8_SA(1, 0), cA + kstep, voffA); PG8_STAGE(PG8_SB(1, 1), cB + hstepB + kstep, voffB);
    epi_prep<MODE>(E, cur, rsl);
    if (wr == 1) PG8_BAR;
    PG8_WAIT_V(8); PG8_BAR;
    PG8_WAIT_V(6); PG8_BAR;
    for (;;) {
        const bool has_next = S.next(ui + 1, nxt);
        const char* nA = has_next ? UNIT_A(nxt) : cA; const char* nB = has_next ? (const char*)gBt + (size_t)nxt.pn * tstepB : cB;
        for (int t = 0; t < nt; t += 2) {
            const bool last = (t == nt - 2);
            const char* a1 = cA + (size_t)(t + 1) * kstep;
            const char* a2 = last ? nA : cA + (size_t)(t + 2) * kstep; const char* b2 = last ? nB : cB + (size_t)(t + 2) * kstep;
            const char* a3 = a2 + kstep; const char* b3 = b2 + kstep;
            const int rflag = __builtin_amdgcn_readfirstlane((RELAX && t == 0 && ui > 0) ? 1 : 0);
            PG8_LDB(B0, 0, 0); PG8_LDB(B1, 0, 1); PG8_SCHED; PG8_LDA(At, 0, 0); PG8_STAGE(PG8_SA(1, 1), a1 + hstepA, voffA);
            if constexpr (RELAX) PG8_WAIT_V8_OR24(rflag); else PG8_WAIT_V(8);
            PG8_WAIT_L(0); PG8_BAR; PG8_MMA(0, 0, At, B0); PG8_MMA(0, 1, At, B1); PG8_BAR; PG8_SCHED;
            PG8_LDA(At, 0, 1); PG8_STAGE(PG8_SB(0, 0), b2, voffB); PG8_STAGE(PG8_SB(0, 1), b2 + hstepB, voffB); PG8_STAGE(PG8_SA(0, 0), a2, voffA);
            if constexpr (RELAX) PG8_WAIT_V8_OR24(rflag); else PG8_WAIT_V(8);
            PG8_WAIT_L(0); PG8_BAR; PG8_MMA(1, 0, At, B0); PG8_MMA(1, 1, At, B1); PG8_BAR; PG8_SCHED;
            PG8_LDB(B0, 1, 0); PG8_LDB(B1, 1, 1); PG8_SCHED; PG8_LDA(At, 1, 0); PG8_STAGE(PG8_SA(0, 1), a2 + hstepA, voffA);
            PG8_WAIT_V(8); PG8_WAIT_L(0); PG8_BAR; PG8_MMA(0, 0, At, B0); PG8_MMA(0, 1, At, B1); PG8_BAR; PG8_SCHED;
            PG8_LDA(At, 1, 1); PG8_STAGE(PG8_SB(1, 0), b3, voffB); PG8_STAGE(PG8_SB(1, 1), b3 + hstepB, voffB); PG8_STAGE(PG8_SA(1, 0), a3, voffA);
            PG8_WAIT_V(8); PG8_WAIT_L(0); PG8_BAR; PG8_MMA(1, 0, At, B0); PG8_MMA(1, 1, At, B1); PG8_BAR; PG8_SCHED;
        }
        if (wr == 0) PG8_BAR;
        epi_run<MODE>(E, acc, cur, wr, wc, fr, fq, rsl + slot * 256);
        if (!has_next) break;
        const bool new_panel = (nxt.pm != cur.pm);
        cur = nxt; cA = nA; cB = nB; ++ui;
        ACC_INIT(cur);
        if (new_panel) { slot ^= 1; epi_prep<MODE>(E, cur, rsl + slot * 256); }
        if (wr == 1) PG8_BAR;
    }
    PG8_WAIT_V(0);
    PG8_BAR;
#undef PG8_SA
#undef PG8_SB
#undef PG8_STAGE
#undef PG8_LDA
#undef PG8_LDB
#undef PG8_MMA
#undef PG8_WAIT_V
#undef PG8_WAIT_L
#undef PG8_WAIT_V8_OR24
#undef PG8_BAR
#undef PG8_SCHED
#undef UNIT_A
#undef ACC_INIT
}

__device__ __forceinline__ void p0_transpose_item(const float* W, const float* sc, int K, int N, bf16_t* WT, LAS float* scr, int item, int lane) {
    const int nblk = N / 64, kb = item / nblk, nb = item % nblk, k0 = 64 * kb, n0 = 64 * nb;
    const int r = lane >> 4, c16 = lane & 15;
    f32x4 v[16];
    const float* src = W + (size_t)(k0 + r) * N + n0 + 4 * c16;
#pragma unroll
    for (int i = 0; i < 16; ++i) v[i] = __builtin_nontemporal_load((const f32x4*)(src + (size_t)(4 * i) * N));
    const int c = lane & 7;
    f32x4 s0 = (f32x4){1.f, 1.f, 1.f, 1.f}, s1 = s0;
    if (sc) { s0 = *(const f32x4*)(sc + k0 + 8 * c); s1 = *(const f32x4*)(sc + k0 + 8 * c + 4); }
#pragma unroll
    for (int i = 0; i < 16; ++i) { LAS float* d = scr + (4 * i + r) * 65 + 4 * c16; d[0] = v[i].x; d[1] = v[i].y; d[2] = v[i].z; d[3] = v[i].w; }
    LDS_WAIT(); asm volatile("" ::: "memory");
#pragma unroll
    for (int j = 0; j < 8; ++j) { const int n = (lane >> 3) + 8 * j; const LAS float* s = scr + (8 * c) * 65 + n;
        u32x4 o; o.x = cvt_pk_bf16(s[0 * 65] * s0.x, s[1 * 65] * s0.y); o.y = cvt_pk_bf16(s[2 * 65] * s0.z, s[3 * 65] * s0.w);
        o.z = cvt_pk_bf16(s[4 * 65] * s1.x, s[5 * 65] * s1.y); o.w = cvt_pk_bf16(s[6 * 65] * s1.z, s[7 * 65] * s1.w);
        *(u32x4*)(WT + (size_t)(n0 + n) * K + k0 + 8 * c) = o; }
    LDS_WAIT(); asm volatile("" ::: "memory");
}

__device__ __forceinline__ void p0_phase(LAS unsigned char* lds, const Args& a, const bool skip_l1mlp) {
    const int tid = threadIdx.x, wave = __builtin_amdgcn_readfirstlane(tid >> 6), lane = tid & 63;
    LAS float* scr = (LAS float*)(lds + wave * 16640);
    const int gw = blockIdx.x * 8 + wave, NGW = gridDim.x * 8;
    unsigned char* ws = a.ws;
    constexpr int I_AIN = 32 * 64, I_SQ = 32 * 32, I_W1 = 32 * 128, I_W2 = 128 * 32, I_GRP = 8 * 8;
    constexpr int NITEMS = I_AIN + 3 * I_SQ + 2 * I_W1 + 2 * I_W2;
    for (int it = gw; it < NITEMS; it += NGW) {
        int r = it;
        if (r < I_W1) { if (!skip_l1mlp) p0_transpose_item(a.mlp_w1, a.norm_mlp, DM, FF, (bf16_t*)(ws + WS_WT_W1_0), scr, r, lane); continue; } r -= I_W1;
        if (r < I_W1) { if (!skip_l1mlp) p0_transpose_item(a.mlp_w1 + (size_t)DM * FF, a.norm_mlp + DM, DM, FF, (bf16_t*)(ws + WS_WT_W1_1), scr, r, lane); continue; } r -= I_W1;
        if (r < I_W2) { if (!skip_l1mlp) p0_transpose_item(a.mlp_w2, nullptr, FF, DM, (bf16_t*)(ws + WS_WT_W2_0), scr, r, lane); continue; } r -= I_W2;
        if (r < I_W2) { if (!skip_l1mlp) p0_transpose_item(a.mlp_w2 + (size_t)DM * FF, nullptr, FF, DM, (bf16_t*)(ws + WS_WT_W2_1), scr, r, lane); continue; } r -= I_W2;
        if (r < I_AIN) { p0_transpose_item(a.a_w_in, a.norm_mix, DM, 4096, (bf16_t*)(ws + WS_WT_AIN), scr, r, lane); continue; } r -= I_AIN;
        if (r < I_SQ) { p0_transpose_item(a.a_w_out, nullptr, DM, DM, (bf16_t*)(ws + WS_WT_AOUT), scr, r, lane); continue; } r -= I_SQ;
        if (r < I_SQ) { p0_transpose_item(a.b_w_in, a.norm_mix + DM, DM, DM, (bf16_t*)(ws + WS_WT_BIN), scr, r, lane); continue; } r -= I_SQ;
        p0_transpose_item(a.b_w_out, a.b_scale, DM, DM, (bf16_t*)(ws + WS_WT_BOUT), scr, r, lane);
    }
    for (int it = gw; it < 2048; it += NGW) {
        const f32x4* sp = (const f32x4*)(a.b_w_grp + (size_t)it * 512) + 2 * lane; const f32x4 p = sp[0], q = sp[1];
        u32x4 o; o.x = cvt_pk_bf16(p.x, p.y); o.y = cvt_pk_bf16(p.z, p.w); o.z = cvt_pk_bf16(q.x, q.y); o.w = cvt_pk_bf16(q.z, q.w);
        *((u32x4*)((bf16_t*)(ws + WS_WT_GRP) + (size_t)it * 512) + lane) = o;
    }
    bf16_t* XB = (bf16_t*)(ws + WS_HB); float* XST = (float*)(ws + WS_XST);
    for (int m = gw; m < MTOK; m += NGW) {
        const f32x4* xr = (const f32x4*)(a.x + (size_t)m * DM) + lane;
        f32x4 v[8]; float s = 0.f;
#pragma unroll
        for (int j = 0; j < 8; ++j) { v[j] = __builtin_nontemporal_load(xr + 64 * j); s += (v[j].x * v[j].x + v[j].y * v[j].y) + (v[j].z * v[j].z + v[j].w * v[j].w); }
        s = wave_sum(s);
        u32x2* o8 = (u32x2*)(XB + (size_t)m * DM) + lane;
#pragma unroll
        for (int j = 0; j < 8; ++j) { u32x2 w; w.x = cvt_pk_bf16(v[j].x, v[j].y); w.y = cvt_pk_bf16(v[j].z, v[j].w); o8[64 * j] = w; }
        if (lane < 32) XST[(size_t)m * 32 + lane] = (lane == 0) ? s : 0.f;
    }
}

__device__ __forceinline__ void spatial_phase(LAS unsigned char* lds, const Args& a, int first, int stride) {
    const int tid = threadIdx.x, wid = __builtin_amdgcn_readfirstlane(tid >> 6), lane = tid & 63, fr = lane & 15, fq = lane >> 4;
    LAS unsigned* VT = (LAS unsigned*)lds;
    LAS unsigned char* WL = lds + 69632;
    LAS float* MR = (LAS float*)(lds + 104448);
    const bf16_t* Z = (const bf16_t*)(a.ws + WS_ACT);
    bf16_t* GATED = (bf16_t*)(a.ws + WS_ACT + (size_t)MTOK * 4096 * 2);
    const float* VST = (const float*)(a.ws + WS_VST);
    for (int it = first; it < 512; it += stride) {
        const int g = it & 7, tok0 = (it >> 3) * 128;
        if (tid < 256) {
            const int row = tid >> 1, half = tid & 1;
            const f32x4* p = (const f32x4*)(VST + ((size_t)(tok0 + row) * 32 + half * 16) * 2);
            float s1 = 0.f, s2 = 0.f;
#pragma unroll
            for (int j = 0; j < 8; ++j) { const f32x4 q = p[j]; s1 += q.x + q.z; s2 += q.y + q.w; }
            s1 += __shfl_xor(s1, 1); s2 += __shfl_xor(s2, 1);
            const float mean = s1 * (1.0f / 2048.0f), var = s2 * (1.0f / 2048.0f) - mean * mean;
            if (!half) { MR[row] = mean; MR[128 + row] = __builtin_amdgcn_rsqf(var + EPS); }
        }
        const float* Wg = a.a_w_s + (size_t)g * 16384;
#pragma unroll
        for (int i = 0; i < 8; ++i) {
            const int idx = (i * 512 + tid) * 4, t = idx >> 7, s = idx & 127;
            f32x4 w = *(const f32x4*)(Wg + idx);
            w.x = (s <= t) ? w.x : 0.f; w.y = (s + 1 <= t) ? w.y : 0.f; w.z = (s + 2 <= t) ? w.z : 0.f; w.w = (s + 3 <= t) ? w.w : 0.f;
            u32x2 o; o.x = cvt_pk_bf16(w.x, w.y); o.y = cvt_pk_bf16(w.z, w.w);
            *(LAS u32x2*)(WL + (t * 136 + s) * 2) = o;
        }
        __syncthreads();
        {
            const float m0 = MR[2 * lane], m1 = MR[2 * lane + 1], r0 = MR[128 + 2 * lane], r1 = MR[128 + 2 * lane + 1];
#pragma unroll
            for (int pass = 0; pass < 4; ++pass) {
                const int d0 = (wid + 8 * pass) * 8;
                const bf16_t* zp = Z + (size_t)(tok0 + 2 * lane) * 4096 + 2048 + g * 256 + d0;
                const u32x4 va = *(const u32x4*)zp, vb = *(const u32x4*)(zp + 4096);
                const f32x4 g0 = *(const f32x4*)(a.a_ln_g + g * 256 + d0), g1 = *(const f32x4*)(a.a_ln_g + g * 256 + d0 + 4);
                const f32x4 b0 = *(const f32x4*)(a.a_ln_b + g * 256 + d0), b1 = *(const f32x4*)(a.a_ln_b + g * 256 + d0 + 4);
                const float gg[8] = {g0.x, g0.y, g0.z, g0.w, g1.x, g1.y, g1.z, g1.w}, bb[8] = {b0.x, b0.y, b0.z, b0.w, b1.x, b1.y, b1.z, b1.w};
#pragma unroll
                for (int i = 0; i < 8; ++i) {
                    const unsigned wa = va[i >> 1], wb = vb[i >> 1];
                    const float x0 = (i & 1) ? bf_hi(wa) : bf_lo(wa), x1 = (i & 1) ? bf_hi(wb) : bf_lo(wb);
                    const float y0 = (x0 - m0) * r0 * gg[i] + bb[i], y1 = (x1 - m1) * r1 * gg[i] + bb[i];
                    VT[(d0 + i) * 68 + lane] = cvt_pk_bf16(y0, y1);
                }
            }
        }
        __syncthreads();
        f32x4 acc[8][2];
#pragma unroll
        for (int mt = 0; mt < 8; ++mt) { acc[mt][0] = (f32x4){0.f, 0.f, 0.f, 0.f}; acc[mt][1] = (f32x4){0.f, 0.f, 0.f, 0.f}; }
        bf16x8 X[2][4];
#pragma unroll
        for (int nd = 0; nd < 2; ++nd)
#pragma unroll
            for (int kk = 0; kk < 4; ++kk) X[nd][kk] = *(const LAS bf16x8*)(lds + ((32 * wid + 16 * nd + fr) * 136 + 32 * kk + 8 * fq) * 2);
#pragma unroll
        for (int mt = 0; mt < 8; ++mt)
#pragma unroll
            for (int kk = 0; kk < 4; ++kk)
                if (32 * kk <= 16 * mt + 15) {
                    const bf16x8 Y = *(const LAS bf16x8*)(WL + ((16 * mt + fr) * 136 + 32 * kk + 8 * fq) * 2);
                    acc[mt][0] = __builtin_amdgcn_mfma_f32_16x16x32_bf16(X[0][kk], Y, acc[mt][0], 0, 0, 0);
                    acc[mt][1] = __builtin_amdgcn_mfma_f32_16x16x32_bf16(X[1][kk], Y, acc[mt][1], 0, 0, 0);
                }
#pragma unroll
        for (int mt = 0; mt < 8; ++mt) {
            const int t = 16 * mt + fr; const float bias = a.a_b_s[g * 128 + t];
#pragma unroll
            for (int nd = 0; nd < 2; ++nd) {
                const int d = 32 * wid + 16 * nd + 4 * fq;
                const u32x2 uu = *(const u32x2*)(Z + (size_t)(tok0 + t) * 4096 + g * 256 + d);
                const f32x4 sv = acc[mt][nd] + bias;
                u32x2 o; o.x = cvt_pk_bf16(sv.x * bf_lo(uu.x), sv.y * bf_hi(uu.x)); o.y = cvt_pk_bf16(sv.z * bf_lo(uu.y), sv.w * bf_hi(uu.y));
                *(u32x2*)(GATED + (size_t)(tok0 + t) * DM + g * 256 + d) = o;
            }
        }
        __syncthreads();
    }
}

__device__ __forceinline__ void unpack8(const u32x4 w, float (&f)[8]) {
    f[0] = bf_lo(w.x); f[1] = bf_hi(w.x); f[2] = bf_lo(w.y); f[3] = bf_hi(w.y); f[4] = bf_lo(w.z); f[5] = bf_hi(w.z); f[6] = bf_lo(w.w); f[7] = bf_hi(w.w);
}
template <int W>
__device__ __forceinline__ void pool_run(const bf16_t* vp, bf16_t* pp, int p0) {
    u32x4 raw[W + 15];
#pragma unroll
    for (int j = 0; j < W + 15; ++j) { const int row = j - (W - 1);
        raw[j] = (row >= 0 || p0 > 0) ? *(const u32x4*)(vp + (ptrdiff_t)row * DM) : (u32x4){0u, 0u, 0u, 0u}; }
    float sum[8];
#pragma unroll
    for (int k = 0; k < 8; ++k) sum[k] = 0.f;
#pragma unroll
    for (int j = 0; j < W - 1; ++j) { float f[8]; unpack8(raw[j], f);
#pragma unroll
        for (int k = 0; k < 8; ++k) sum[k] += f[k]; }
#pragma unroll
    for (int i = 0; i < 16; ++i) {
        const int p = p0 + i; float c[8], f[8]; unpack8(raw[W - 1 + i], c); unpack8(raw[i], f);
        const int cnt = (p + 1 < W) ? (p + 1) : W; const float inv = 1.0f / (float)cnt;
        float o[8];
#pragma unroll
        for (int k = 0; k < 8; ++k) { sum[k] += c[k]; o[k] = sum[k] * inv - c[k]; sum[k] -= f[k]; }
        u32x4 ov; ov.x = cvt_pk_bf16(o[0], o[1]); ov.y = cvt_pk_bf16(o[2], o[3]); ov.z = cvt_pk_bf16(o[4], o[5]); ov.w = cvt_pk_bf16(o[6], o[7]);
        *(u32x4*)(pp + (size_t)i * DM) = ov;
    }
}
__device__ __forceinline__ void pool_phase(const Args& a, int first_blk, int nblk) {
    const bf16_t* V = (const bf16_t*)(a.ws + WS_ACT);
    bf16_t* P = (bf16_t*)(a.ws + WS_ACT + (size_t)MTOK * DM * 2);
    for (int gid = first_blk * 512 + (int)threadIdx.x; gid < (MTOK / 16) * 256; gid += nblk * 512) {
        const int cc = gid & 255, t0 = (gid >> 8) * 16, p0 = t0 & (SEQ - 1);
        const int grp = __builtin_amdgcn_readfirstlane(cc >> 6);
        const bf16_t* vp = V + (size_t)t0 * DM + cc * 8; bf16_t* pp = P + (size_t)t0 * DM + cc * 8;
        if (grp == 0) pool_run<2>(vp, pp, p0); else if (grp == 1) pool_run<4>(vp, pp, p0); else if (grp == 2) pool_run<8>(vp, pp, p0); else pool_run<16>(vp, pp, p0);
    }
}

__device__ __forceinline__ void final_phase(const Args& a) {
    const int tid = threadIdx.x, wave = tid >> 6, lane = tid & 63;
    const float* HST = (const float*)(a.ws + WS_HST4);
    for (int m = blockIdx.x * 8 + wave; m < MTOK; m += gridDim.x * 8) {
        float s = (lane < 32) ? HST[(size_t)m * 32 + lane] : 0.f;
        s = wave_sum(s);
        const float r = __builtin_amdgcn_rsqf(s * (1.0f / DM) + EPS);
        f32x4* op = (f32x4*)(a.out + (size_t)m * DM) + lane; const f32x4* gp = (const f32x4*)a.final_norm + lane;
#pragma unroll
        for (int j = 0; j < 8; ++j) { const f32x4 v = op[64 * j], gg = gp[64 * j]; op[64 * j] = v * r * gg; }
    }
}

#define XB_TMO      128
#define XB_XCNT(j)  (256  + 64 * (j))
#define XB_XSUB(j)  (1280 + 64 * (j))
#define XB_XGEN(j)  (2304 + 64 * (j))
#define XB_TOP      3328
#define XB_TOPGEN   3392
#define XCD_BAR_WORDS 3456
#define XB_SPIN_CAP (1u << 18)
__device__ __forceinline__ unsigned xb_ld(unsigned* p)              { return __hip_atomic_load(p, __ATOMIC_RELAXED, __HIP_MEMORY_SCOPE_AGENT); }
__device__ __forceinline__ unsigned xb_add(unsigned* p, unsigned v) { return __hip_atomic_fetch_add(p, v, __ATOMIC_RELAXED, __HIP_MEMORY_SCOPE_AGENT); }
__device__ __forceinline__ unsigned xb_xcc_id() { return (unsigned)__builtin_amdgcn_s_getreg((3 << 11) | 20) & 0xFu; }
#define XB_SPIN(cond, bar) do { unsigned _sp = 0; while (cond) { __builtin_amdgcn_s_sleep(1); \
    if ((++_sp & 255u) == 0u) { if (xb_ld(&(bar)[XB_TMO])) break; if (_sp > XB_SPIN_CAP) { atomicAdd(&(bar)[XB_TMO], 1u); break; } } } } while (0)
struct XcdBarrier { unsigned* bar; unsigned x; volatile LAS unsigned* st; };
__device__ __forceinline__ XcdBarrier xcd_barrier_post(unsigned* bar, volatile LAS unsigned* st) {
    XcdBarrier b; b.bar = bar; b.x = xb_xcc_id(); b.st = st;
    if (threadIdx.x == 0) (void)xb_add(&bar[XB_XCNT(b.x)], 1u);
    return b;
}
__device__ __forceinline__ void xcd_barrier_complete(unsigned* bar, unsigned x, unsigned& nloc, unsigned& nx) {
    const unsigned G = gridDim.x * gridDim.y * gridDim.z;
    unsigned sum, cnt, mine, sp = 0u;
    for (;;) {
        sum = 0u; cnt = 0u; mine = 0u;
#pragma unroll
        for (unsigned j = 0; j < 16; ++j) { const unsigned c = xb_ld(&bar[XB_XCNT(j)]); sum += c; cnt += (c > 0u) ? 1u : 0u; mine = (j == x) ? c : mine; }
        if (sum == G) break;
        __builtin_amdgcn_s_sleep(1);
        if ((++sp & 255u) == 0u) { if (xb_ld(&bar[XB_TMO])) break; if (sp > XB_SPIN_CAP) { atomicAdd(&bar[XB_TMO], 1u); break; } }
    }
    nloc = mine > 0u ? mine : 1u; nx = cnt > 0u ? cnt : 1u;
}
__device__ __forceinline__ void seam_convert(LAS unsigned char* lds, const Args& a, int batch) {
    const int tid = threadIdx.x, wave = __builtin_amdgcn_readfirstlane(tid >> 6), lane = tid & 63;
    if (wave >= 1 && wave <= 4) {
        LAS float* scr = (LAS float*)(lds + wave * 16640);
        const int base = (batch & 3) * 1024;
        for (int it = base + (int)blockIdx.x * 4 + (wave - 1); it < base + 1024; it += (int)gridDim.x * 4) {
            if (batch < 4) p0_transpose_item(a.mlp_w1 + (size_t)DM * FF, a.norm_mlp + DM, DM, FF, (bf16_t*)(a.ws + WS_WT_W1_1), scr, it, lane);
            else p0_transpose_item(a.mlp_w2 + (size_t)DM * FF, nullptr, FF, DM, (bf16_t*)(a.ws + WS_WT_W2_1), scr, it, lane);
        }
    }
}
__device__ __forceinline__ void seam_warm(LAS unsigned char* lds, const bf16_t* p, int wave_lo, const bool skip_last_quarter) {
    const int tid = threadIdx.x, wave = __builtin_amdgcn_readfirstlane(tid >> 6), lane = tid & 63;
    if (wave >= wave_lo) {
        const int nw = 8 - wave_lo;
        const char* base = (const char*)p + lane * 16;
        for (int i = (int)blockIdx.x * nw + (wave - wave_lo); i < 32768; i += (int)gridDim.x * nw)
            if (!(skip_last_quarter && (i & 15) >= 12)) __builtin_amdgcn_global_load_lds((const unsigned*)(base + (size_t)i * 1024), (LAS unsigned*)(lds + 98304 + wave * 1024), 16, 0, 0);
        asm volatile("s_waitcnt vmcnt(0)" ::: "memory");
    }
}
template <bool CONV>
__device__ __forceinline__ void xcd_barrier_t(const XcdBarrier& b, LAS unsigned char* lds, const Args& a, int batch, const bf16_t* warm = nullptr, int warm_lo = 8) {
    asm volatile("s_waitcnt vmcnt(0)" ::: "memory");
    __syncthreads();
    if (threadIdx.x == 0) {
        unsigned* bar = b.bar;
        __builtin_amdgcn_s_waitcnt(0);
        unsigned nloc = b.st[0], nx = b.st[1];
        if (nloc == 0u) { xcd_barrier_complete(bar, b.x, nloc, nx); b.st[0] = nloc; b.st[1] = nx; }
        const unsigned old = xb_add(&bar[XB_XSUB(b.x)], 1u);
        const unsigned gen = old / nloc;
        if (old + 1u == (gen + 1u) * nloc) {
            __builtin_amdgcn_fence(__ATOMIC_RELEASE, "agent");
            asm volatile("s_waitcnt vmcnt(0)" ::: "memory");
            const unsigned og = xb_add(&bar[XB_TOP], 1u);
            const unsigned tg = og / nx;
            if (og + 1u == (tg + 1u) * nx) xb_add(&bar[XB_TOPGEN], 1u);
            else XB_SPIN(xb_ld(&bar[XB_TOPGEN]) == tg, bar);
            __builtin_amdgcn_fence(__ATOMIC_ACQUIRE, "agent");
            asm volatile("s_waitcnt vmcnt(0)" ::: "memory");
        } else {
            XB_SPIN(xb_ld(&bar[XB_TOPGEN]) == gen, bar);
            __builtin_amdgcn_fence(__ATOMIC_ACQUIRE, "agent");
            asm volatile("s_waitcnt vmcnt(0)" ::: "memory");
        }
    }
    if constexpr (CONV) seam_convert(lds, a, batch);
    if (warm) seam_warm(lds, warm, warm_lo, !CONV);
    __syncthreads();
}
__device__ __forceinline__ void xcd_barrier(const XcdBarrier& b, LAS unsigned char* lds, const Args& a) { xcd_barrier_t<false>(b, lds, a, -1); }

__device__ __forceinline__ void jit_convert(LAS unsigned char* lds, const float* W, const float* sc, int K, int N, bf16_t* WT) {
    const int tid = threadIdx.x, wave = __builtin_amdgcn_readfirstlane(tid >> 6), lane = tid & 63;
    LAS float* scr = (LAS float*)(lds + wave * 16640);
    for (int it = (int)blockIdx.x * 8 + wave; it < 4096; it += (int)gridDim.x * 8) p0_transpose_item(W, sc, K, N, WT, scr, it, lane);
}

__global__ void __launch_bounds__(512, 2) mega_fwd(Args a) {
    extern __shared__ __attribute__((aligned(16))) unsigned char lds_raw[];
    LAS unsigned char* lds = (LAS unsigned char*)lds_raw;
    cg::grid_group grid = cg::this_grid();
    unsigned char* ws = a.ws;
    const int lo = a.ph_lo, hi = a.ph_hi;
#define IN(k) (lo <= (k) && (k) < hi)
    const bool multi = (hi - lo) > 1, use_cg = hi > 64;
    volatile LAS unsigned* xst = (volatile LAS unsigned*)(lds + XB_ST_OFF);
    if (threadIdx.x < 2) xst[threadIdx.x] = 0u;
    __syncthreads();
    XcdBarrier bar; bar.bar = (unsigned*)(ws + WS_BAR); bar.x = 0; bar.st = xst;
    if (multi && !use_cg) bar = xcd_barrier_post((unsigned*)(ws + WS_BAR), xst);
    const bool seamconv = multi && !use_cg && IN(0) && IN(11);
#define SEAM_BATCH(k) ((k) == 1 ? 0 : (k) == 2 ? 1 : (k) == 3 ? 2 : (k) == 4 ? 3 : (k) == 5 ? 4 : (k) == 6 ? 5 : (k) == 7 ? 6 : (k) == 9 ? 7 : -1)
#define SEAM(k) do { if (IN(k) && ((k) == 7 ? IN(9) : IN((k) + 1))) { if (use_cg) grid.sync(); else if (seamconv && SEAM_BATCH(k) >= 0) xcd_barrier_t<true>(bar, lds, a, SEAM_BATCH(k)); else xcd_barrier(bar, lds, a); } } while (0)
    bf16_t* HB = (bf16_t*)(ws + WS_HB); bf16_t* ACT = (bf16_t*)(ws + WS_ACT);
    if (IN(0)) p0_phase(lds, a, seamconv);
#if DUP_PHASE == 0
    if (IN(0)) p0_phase(lds, a, seamconv);
#endif
    SEAM(0);
    if (IN(1)) { Epi E{0, ACT, 4096, nullptr, nullptr, (float*)(ws + WS_VST), (const float*)(ws + WS_XST)};
        gemm_phase<0, 4096, 2048, 2048, false>(lds, HB, (const bf16_t*)(ws + WS_WT_AIN), E, (int)gridDim.x, (int)blockIdx.x); }
#if DUP_PHASE == 1
    if (IN(1)) { Epi E{0, ACT, 4096, nullptr, nullptr, (float*)(ws + WS_VST), (const float*)(ws + WS_XST)};
        gemm_phase<0, 4096, 2048, 2048, false>(lds, HB, (const bf16_t*)(ws + WS_WT_AIN), E, (int)gridDim.x, (int)blockIdx.x); }
#endif
    if (seamconv) { if (IN(1) && IN(2)) xcd_barrier_t<true>(bar, lds, a, SEAM_BATCH(1), (const bf16_t*)a.mlp_w1, 5); }
    else SEAM(1);
    if (IN(2)) spatial_phase(lds, a, (int)blockIdx.x, (int)gridDim.x);
    if (seamconv) { if (IN(2) && IN(3)) xcd_barrier_t<true>(bar, lds, a, SEAM_BATCH(2), (const bf16_t*)(a.mlp_w1 + (size_t)8388608), 5); }
    else SEAM(2);
    if (IN(3)) { Epi E{6, HB, DM, nullptr, nullptr, (float*)(ws + WS_HST1), nullptr, nullptr, nullptr, HB};
        gemm_phase<6, 2048, 2048, 2048, false>(lds, ACT + (size_t)MTOK * 4096, (const bf16_t*)(ws + WS_WT_AOUT), E, (int)gridDim.x, (int)blockIdx.x); }
    if (seamconv) jit_convert(lds, a.mlp_w1, a.norm_mlp, DM, FF, (bf16_t*)(ws + WS_WT_W1_0));
    SEAM(3);
    if (IN(4)) { Epi E{2, ACT, FF, nullptr, nullptr, nullptr, (const float*)(ws + WS_HST1)};
        gemm_phase<2, 8192, 2048, 2048, false>(lds, HB, (const bf16_t*)(ws + WS_WT_W1_0), E, (int)gridDim.x, (int)blockIdx.x); }
#if DUP_PHASE == 4
    if (IN(4)) { Epi E{2, ACT, FF, nullptr, nullptr, nullptr, (const float*)(ws + WS_HST1)};
        gemm_phase<2, 8192, 2048, 2048, false>(lds, HB, (const bf16_t*)(ws + WS_WT_W1_0), E, (int)gridDim.x, (int)blockIdx.x); }
#endif
    if (seamconv) jit_convert(lds, a.mlp_w2, nullptr, FF, DM, (bf16_t*)(ws + WS_WT_W2_0));
    SEAM(4);
    if (IN(5)) { Epi E{6, HB, DM, nullptr, nullptr, (float*)(ws + WS_HST2), nullptr, nullptr, nullptr, HB};
        gemm_phase<6, 2048, 8192, 8192, false>(lds, ACT, (const bf16_t*)(ws + WS_WT_W2_0), E, (int)gridDim.x, (int)blockIdx.x); }
    SEAM(5);
    if (IN(6)) { Epi E{3, ACT, DM, nullptr, nullptr, nullptr, (const float*)(ws + WS_HST2)};
        gemm_phase<3, 2048, 2048, 2048, false>(lds, HB, (const bf16_t*)(ws + WS_WT_BIN), E, (int)gridDim.x, (int)blockIdx.x); }
#if DUP_PHASE == 6
    if (IN(6)) { Epi E{3, ACT, DM, nullptr, nullptr, nullptr, (const float*)(ws + WS_HST2)};
        gemm_phase<3, 2048, 2048, 2048, false>(lds, HB, (const bf16_t*)(ws + WS_WT_BIN), E, (int)gridDim.x, (int)blockIdx.x); }
#endif
    SEAM(6);
    if (IN(7)) {
        const bool split = gridDim.x >= 128;
        const int gwc = split ? 64 : (int)gridDim.x;
        if ((int)blockIdx.x < gwc) { Epi E{4, (bf16_t*)(ws + WS_WCT), DM, nullptr, nullptr, nullptr, nullptr};
            gemm_phase<4, 2048, 512, 2048, true, 2048>(lds, (const bf16_t*)(ws + WS_WT_BOUT), (const bf16_t*)(ws + WS_WT_GRP), E, gwc, (int)blockIdx.x); }
        if (split) { if (blockIdx.x >= 64) pool_phase(a, (int)blockIdx.x - 64, (int)gridDim.x - 64); }
        else pool_phase(a, (int)blockIdx.x, (int)gridDim.x);
    }
    SEAM(7);
    if (IN(9)) { Epi E{6, HB, DM, nullptr, nullptr, (float*)(ws + WS_HST3), nullptr, nullptr, nullptr, HB};
        gemm_phase<6, 2048, 2048, 2048, false>(lds, ACT + (size_t)MTOK * DM, (const bf16_t*)(ws + WS_WCT), E, (int)gridDim.x, (int)blockIdx.x); }
    if (seamconv) { if (IN(9) && IN(10)) xcd_barrier_t<true>(bar, lds, a, SEAM_BATCH(9), (const bf16_t*)(ws + WS_WT_W1_1), 5); }
    else SEAM(9);
    if (IN(10)) { Epi E{2, ACT, FF, nullptr, nullptr, nullptr, (const float*)(ws + WS_HST3)};
        gemm_phase<2, 8192, 2048, 2048, false>(lds, HB, (const bf16_t*)(ws + WS_WT_W1_1), E, (int)gridDim.x, (int)blockIdx.x); }
    if (seamconv) { if (IN(10) && IN(11)) xcd_barrier_t<false>(bar, lds, a, -1, (const bf16_t*)(ws + WS_WT_W2_1), 1); }
    else SEAM(10);
#if FUSE_FINAL
    if (IN(11)) { Epi E{5, nullptr, DM, a.out, nullptr, (float*)(ws + WS_HST4), nullptr, (unsigned*)(ws + WS_BAR + 16384), a.final_norm, HB};
        gemm_phase<5, 2048, 8192, 8192, false>(lds, ACT, (const bf16_t*)(ws + WS_WT_W2_1), E, (int)gridDim.x, (int)blockIdx.x); }
#else
    if (IN(11)) { Epi E{1, nullptr, DM, a.out, a.out, (float*)(ws + WS_HST4), nullptr};
        gemm_phase<1, 2048, 8192, 8192, false>(lds, ACT, (const bf16_t*)(ws + WS_WT_W2_1), E, (int)gridDim.x, (int)blockIdx.x); }
    SEAM(11);
    if (IN(12)) final_phase(a);
#endif
#undef IN
#undef SEAM
}

extern "C" void kernel_launch(void* const* d_in, const int* in_sizes, int n_in, void* d_out, int out_size, void* d_ws, size_t ws_size, hipStream_t stream) {
    static int grid = 0;
    if (grid == 0) {
        if (n_in != 16 || out_size != MTOK * DM || ws_size < WS_END) { fprintf(stderr, "kernel_launch: unexpected shapes (n_in %d out %d ws %zu need %zu)\n", n_in, out_size, ws_size, (size_t)WS_END); grid = -1; return; }
        int dev = 0, cus = 0, per_cu = 0;
        hipGetDevice(&dev);
        hipDeviceGetAttribute(&cus, hipDeviceAttributeMultiprocessorCount, dev);
        hipFuncSetAttribute((const void*)mega_fwd, hipFuncAttributeMaxDynamicSharedMemorySize, LDS_BYTES);
        hipOccupancyMaxActiveBlocksPerMultiprocessor(&per_cu, (const void*)mega_fwd, 512, LDS_BYTES);
        if (per_cu < 1) { fprintf(stderr, "kernel_launch: occupancy query reports %d blocks per CU\n", per_cu); per_cu = 1; }
        (void)hipGetLastError();
        grid = cus * 1;
    }
    if (grid < 0) return;
    Args a{};
    a.x = (const float*)d_in[0]; a.a_w_in = (const float*)d_in[1]; a.a_ln_g = (const float*)d_in[2]; a.a_ln_b = (const float*)d_in[3]; a.a_w_s = (const float*)d_in[4];
    a.a_b_s = (const float*)d_in[5]; a.a_w_out = (const float*)d_in[6]; a.b_w_in = (const float*)d_in[7]; a.b_w_grp = (const float*)d_in[8]; a.b_scale = (const float*)d_in[9];
    a.b_w_out = (const float*)d_in[10]; a.norm_mix = (const float*)d_in[11]; a.norm_mlp = (const float*)d_in[12]; a.mlp_w1 = (const float*)d_in[13]; a.mlp_w2 = (const float*)d_in[14];
    a.final_norm = (const float*)d_in[15]; a.out = (float*)d_out; a.ws = (unsigned char*)d_ws;
#if N_LAUNCH_MODE == 1
    a.ph_lo = 0; a.ph_hi = 13;
    if (hipMemsetAsync((unsigned char*)d_ws + WS_BAR, 0, 32768, stream) != hipSuccess) { fprintf(stderr, "kernel_launch: memset of the barrier words failed\n"); return; }
    void* args[] = {&a};
    hipError_t e = hipLaunchCooperativeKernel((const void*)mega_fwd, dim3(grid), dim3(512), args, LDS_BYTES, stream);
    if (e != hipSuccess) fprintf(stderr, "cooperative launch failed: %s (grid %d)\n", hipGetErrorString(e), grid);
#else
    for (int ph = 0; ph < 13; ++ph) { a.ph_lo = ph; a.ph_hi = ph + 1; hipLaunchKernelGGL(mega_fwd, dim3(grid), dim3(512), LDS_BYTES, stream, a); }
#endif
}
```

```cpp
#include <hip/hip_runtime.h>
#include <hip/hip_cooperative_groups.h>
#include <cstdio>
#include <cstdint>
namespace cg = cooperative_groups;

#define LAS __attribute__((address_space(3)))
typedef unsigned short bf16_t;
typedef short bf16x8 __attribute__((ext_vector_type(8)));
typedef float f32x4 __attribute__((ext_vector_type(4)));
typedef float f32x2 __attribute__((ext_vector_type(2)));
typedef unsigned u32x4 __attribute__((ext_vector_type(4)));
typedef unsigned u32x2 __attribute__((ext_vector_type(2)));

constexpr int MTOK = 8192, DM = 2048, FF = 8192, SEQ = 2048;
constexpr float EPS = 1e-6f;
constexpr int BM = 256, BK = 64, HALF = 128, HTB = HALF * BK * 2, STAGE_BYTES = 8 * HTB, NXCD = 8, WGM = 8;
constexpr int RS_OFF = STAGE_BYTES;
constexpr int XB_ST_OFF = STAGE_BYTES + 2048;
constexpr int LDS_BYTES = STAGE_BYTES + 2048 + 16;

#ifndef DUP_PHASE
#define DUP_PHASE -1
#endif
#define REP(k) ((DUP_PHASE == (k)) ? 2 : 1)
#ifndef FUSE_FINAL
#define FUSE_FINAL 1
#endif
#ifndef N_LAUNCH_MODE
#define N_LAUNCH_MODE 1
#endif

constexpr size_t WS_WT_AIN = 0;
constexpr size_t WS_WT_AOUT = WS_WT_AIN + (size_t)4096 * 2048 * 2;
constexpr size_t WS_WT_W1_0 = WS_WT_AOUT + (size_t)2048 * 2048 * 2;
constexpr size_t WS_WT_W2_0 = WS_WT_W1_0 + (size_t)8192 * 2048 * 2;
constexpr size_t WS_WT_BIN = WS_WT_W2_0 + (size_t)8192 * 2048 * 2;
constexpr size_t WS_WT_GRP = WS_WT_BIN + (size_t)2048 * 2048 * 2;
constexpr size_t WS_WT_BOUT = WS_WT_GRP + (size_t)2048 * 512 * 2;
constexpr size_t WS_WT_W1_1 = WS_WT_BOUT + (size_t)2048 * 2048 * 2;
constexpr size_t WS_WT_W2_1 = WS_WT_W1_1 + (size_t)8192 * 2048 * 2;
constexpr size_t WS_HB = WS_WT_W2_1 + (size_t)8192 * 2048 * 2;
constexpr size_t WS_ACT = WS_HB + (size_t)MTOK * DM * 2;
constexpr size_t WS_XST = WS_ACT + (size_t)MTOK * FF * 2;
constexpr size_t WS_HST1 = WS_XST + (size_t)MTOK * 32 * 4;
constexpr size_t WS_HST2 = WS_HST1 + (size_t)MTOK * 32 * 4;
constexpr size_t WS_HST3 = WS_HST2 + (size_t)MTOK * 32 * 4;
constexpr size_t WS_HST4 = WS_HST3 + (size_t)MTOK * 32 * 4;
constexpr size_t WS_VST = WS_HST4 + (size_t)MTOK * 32 * 4;
constexpr size_t WS_BAR = WS_VST + (size_t)MTOK * 32 * 8;
constexpr size_t WS_WCT = WS_BAR + 32768;
constexpr size_t WS_END = WS_WCT + (size_t)2048 * 2048 * 2;

struct Args {
    const float* x; const float* a_w_in; const float* a_ln_g; const float* a_ln_b; const float* a_w_s; const float* a_b_s; const float* a_w_out;
    const float* b_w_in; const float* b_w_grp; const float* b_scale; const float* b_w_out;
    const float* norm_mix; const float* norm_mlp; const float* mlp_w1; const float* mlp_w2; const float* final_norm;
    float* out; unsigned char* ws; int ph_lo, ph_hi;
};

__device__ __forceinline__ unsigned cvt_pk_bf16(float lo, float hi) { unsigned r; asm volatile("v_cvt_pk_bf16_f32 %0, %1, %2" : "=v"(r) : "v"(lo), "v"(hi)); return r; }
__device__ __forceinline__ float bf_lo(unsigned w) { return __uint_as_float(w << 16); }
__device__ __forceinline__ float bf_hi(unsigned w) { return __uint_as_float(w & 0xffff0000u); }
__device__ __forceinline__ float wave_sum(float v) {
#pragma unroll
    for (int o = 1; o < 64; o <<= 1) v += __shfl_xor(v, o);
    return v;
}
#define LDS_WAIT() asm volatile("s_waitcnt lgkmcnt(0)" ::: "memory")

__device__ __forceinline__ f32x2 gelu_pk(f32x2 v) {
    const f32x2 av = __builtin_elementwise_abs(v), d = av * 0.2316418882f + 1.0f;
    f32x2 t; t.x = __builtin_amdgcn_rcpf(d.x); t.y = __builtin_amdgcn_rcpf(d.y);
    f32x2 q = t * 0.5307027145f + (-0.7265760135f); q = q * t + 0.7107068705f; q = q * t + (-0.142248368f); q = q * t + 0.127414796f; q = q * t;
    const f32x2 s = (v * v) * (-0.72134752044f);
    f32x2 e; e.x = __builtin_amdgcn_exp2f(s.x); e.y = __builtin_amdgcn_exp2f(s.y);
    const f32x2 m = v * (q * e), r = v - m;
    f32x2 o; o.x = v.x < 0.f ? m.x : r.x; o.y = v.y < 0.f ? m.y : r.y; return o;
}

__host__ __device__ __forceinline__ int lds_byte(int r, int c) { const int st = (r >> 4) * 2 + (c >> 5), rr = r & 15, cc = c & 31, ob = rr * 64 + cc * 2; return st * 1024 + (ob ^ (((ob >> 9) & 1) << 5)); }
__host__ __device__ __forceinline__ void stage_rc(int b, int& R, int& C) { const int st = b / 1024, sb = b % 1024, swz = sb ^ (((sb >> 9) & 1) << 5); R = (st >> 1) * 16 + swz / 64; C = (st & 1) * 32 + (swz % 64) / 2; }
__host__ __device__ __forceinline__ int perm32(int rho) { const int n = rho >> 4, i = rho & 15; return 8 * (i >> 2) + 4 * n + (i & 3); }

struct Unit { int pm, pn; };
struct StaticOrder {
    int nM, nN, nwg, G, c;
    __device__ void init(int M, int N, int G_, int c_) { nM = M / BM; nN = N / BM; nwg = nM * nN; G = G_; c = c_; }
    __device__ bool next(int i, Unit& u) const {
        const long L = (long)i * G + c; if (L >= nwg) return false;
        int wgid = (int)L; { const int q = nwg / NXCD, r = nwg % NXCD, xcd = wgid % NXCD, off = wgid / NXCD; wgid = (xcd < r ? xcd * (q + 1) : r * (q + 1) + (xcd - r) * q) + off; }
        const int nig = WGM * nN, gid = wgid / nig, fm = gid * WGM, gsz = (nM - fm) < WGM ? (nM - fm) : WGM;
        u.pm = fm + ((wgid % nig) % gsz); u.pn = (wgid % nig) / gsz; return true;
    }
};
struct Epi { int mode; bf16_t* ob; int ldob; float* of; const float* res; float* st_out; const float* st_in; unsigned* cnt; const float* gain; const bf16_t* resb; };

template <int MODE>
__device__ __forceinline__ void epi_prep(const Epi& E, const Unit& u, LAS float* rs) {
    if (MODE == 0 || MODE == 2 || MODE == 3) {
        const int tid = threadIdx.x, row = tid >> 1, half = tid & 1;
        const f32x4* p = (const f32x4*)(E.st_in + ((size_t)(u.pm * BM + row) * 32 + half * 16));
        const f32x4 a = p[0], b = p[1], c = p[2], d = p[3];
        float s = ((a.x + a.y) + (a.z + a.w)) + ((b.x + b.y) + (b.z + b.w)) + ((c.x + c.y) + (c.z + c.w)) + ((d.x + d.y) + (d.z + d.w));
        s += __shfl_xor(s, 1);
        if (!half) rs[row] = __builtin_amdgcn_rsqf(s * (1.0f / DM) + EPS);
    }
}

template <int MODE>
__device__ __forceinline__ void epi_run(const Epi& E, const f32x4 (&acc)[2][2][4][2], const Unit& u, int wr, int wc, int fr, int fq, const LAS float* rs) {
    const int rl0 = wr * 64 + fr, col0 = u.pn * BM + wc * 32 + 8 * fq;
    constexpr int mode = MODE;
    if (mode == 5) {
        const int lane = fr + 16 * fq;
        unsigned* cw = E.cnt + u.pm * 64;
#pragma unroll
        for (int ai = 0; ai < 2; ++ai)
#pragma unroll
            for (int m = 0; m < 4; ++m) {
                const size_t row = (size_t)(u.pm * BM + rl0 + ai * HALF + m * 16);
                float ss = 0.f;
#pragma unroll
                for (int bj = 0; bj < 2; ++bj) { const f32x4 v0 = acc[ai][bj][m][0], v1 = acc[ai][bj][m][1];
                    ss += (v0.x * v0.x + v0.y * v0.y) + (v0.z * v0.z + v0.w * v0.w) + (v1.x * v1.x + v1.y * v1.y) + (v1.z * v1.z + v1.w * v1.w); }
                ss += __shfl_xor(ss, 16); ss += __shfl_xor(ss, 32);
                if (fq == 0) __hip_atomic_store((unsigned*)(E.st_out + row * 32 + u.pn * 4 + wc), __float_as_uint(ss), __ATOMIC_RELAXED, __HIP_MEMORY_SCOPE_AGENT);
            }
        asm volatile("s_waitcnt vmcnt(0)" ::: "memory");
        if (lane == 0) (void)__hip_atomic_fetch_add(cw, 1u, __ATOMIC_RELAXED, __HIP_MEMORY_SCOPE_AGENT);
        { unsigned sp = 0;
          while ((unsigned)__builtin_amdgcn_readfirstlane(__hip_atomic_load(cw, __ATOMIC_RELAXED, __HIP_MEMORY_SCOPE_AGENT)) < 64u) { __builtin_amdgcn_s_sleep(2); if (++sp > (1u << 22)) break; } }
        __builtin_amdgcn_fence(__ATOMIC_ACQUIRE, "agent");
        asm volatile("s_waitcnt vmcnt(0)" ::: "memory");
        f32x4 gv[2][2];
#pragma unroll
        for (int bj = 0; bj < 2; ++bj) { gv[bj][0] = *(const f32x4*)(E.gain + col0 + bj * HALF); gv[bj][1] = *(const f32x4*)(E.gain + col0 + bj * HALF + 4); }
#pragma unroll
        for (int ai = 0; ai < 2; ++ai)
#pragma unroll
            for (int m = 0; m < 4; ++m) {
                const size_t row = (size_t)(u.pm * BM + rl0 + ai * HALF + m * 16);
                const f32x4* pp = (const f32x4*)(E.st_out + row * 32 + 8 * fq);
                const f32x4 pa = pp[0], pb = pp[1];
                float s = ((pa.x + pa.y) + (pa.z + pa.w)) + ((pb.x + pb.y) + (pb.z + pb.w));
                s += __shfl_xor(s, 16); s += __shfl_xor(s, 32);
                const float r = __builtin_amdgcn_rsqf(s * (1.0f / DM) + EPS);
                float* op = E.of + row * DM + col0;
#pragma unroll
                for (int bj = 0; bj < 2; ++bj) { *(f32x4*)(op + bj * HALF) = acc[ai][bj][m][0] * r * gv[bj][0]; *(f32x4*)(op + bj * HALF + 4) = acc[ai][bj][m][1] * r * gv[bj][1]; }
                asm volatile("" ::: "memory");
            }
    } else if (mode == 1 || mode == 6) {
#pragma unroll
        for (int ai = 0; ai < 2; ++ai)
#pragma unroll
            for (int m = 0; m < 4; ++m) {
                const size_t row = (size_t)(u.pm * BM + rl0 + ai * HALF + m * 16);
                float ss = 0.f;
#pragma unroll
                for (int bj = 0; bj < 2; ++bj) {
                    const f32x4 v0 = acc[ai][bj][m][0], v1 = acc[ai][bj][m][1];
                    ss += (v0.x * v0.x + v0.y * v0.y) + (v0.z * v0.z + v0.w * v0.w) + (v1.x * v1.x + v1.y * v1.y) + (v1.z * v1.z + v1.w * v1.w);
                    u32x4 w; w.x = cvt_pk_bf16(v0.x, v0.y); w.y = cvt_pk_bf16(v0.z, v0.w); w.z = cvt_pk_bf16(v1.x, v1.y); w.w = cvt_pk_bf16(v1.z, v1.w);
                    *(u32x4*)(E.ob + row * E.ldob + col0 + bj * HALF) = w;
                }
                ss += __shfl_xor(ss, 16); ss += __shfl_xor(ss, 32);
                if (fq == 0) E.st_out[row * 32 + u.pn * 4 + wc] = ss;
                asm volatile("" ::: "memory");
            }
    } else {
        const bool vstat = (mode == 0) && (u.pn >= 8);
#pragma unroll
        for (int ai = 0; ai < 2; ++ai)
#pragma unroll
            for (int m = 0; m < 4; ++m) {
                const int rl = rl0 + ai * HALF + m * 16;
                const size_t row = (size_t)(u.pm * BM + rl);
                const float r = (mode == 4) ? 1.0f : rs[rl];
                float s1 = 0.f, s2 = 0.f;
#pragma unroll
                for (int bj = 0; bj < 2; ++bj) {
                    f32x4 v0 = acc[ai][bj][m][0] * r, v1 = acc[ai][bj][m][1] * r;
                    if (mode == 0) {
                        const f32x2 a = gelu_pk((f32x2){v0.x, v0.y}), b = gelu_pk((f32x2){v0.z, v0.w}), c = gelu_pk((f32x2){v1.x, v1.y}), d = gelu_pk((f32x2){v1.z, v1.w});
                        v0 = (f32x4){a.x, a.y, b.x, b.y}; v1 = (f32x4){c.x, c.y, d.x, d.y};
                        s1 += ((v0.x + v0.y) + (v0.z + v0.w)) + ((v1.x + v1.y) + (v1.z + v1.w));
                        s2 += (v0.x * v0.x + v0.y * v0.y) + (v0.z * v0.z + v0.w * v0.w) + (v1.x * v1.x + v1.y * v1.y) + (v1.z * v1.z + v1.w * v1.w);
                    } else if (mode == 2) {
                        v0 = __builtin_elementwise_max(v0, (f32x4){0.f, 0.f, 0.f, 0.f}); v1 = __builtin_elementwise_max(v1, (f32x4){0.f, 0.f, 0.f, 0.f});
                        v0 = v0 * v0; v1 = v1 * v1;
                    }
                    u32x4 w; w.x = cvt_pk_bf16(v0.x, v0.y); w.y = cvt_pk_bf16(v0.z, v0.w); w.z = cvt_pk_bf16(v1.x, v1.y); w.w = cvt_pk_bf16(v1.z, v1.w);
                    *(u32x4*)(E.ob + row * E.ldob + col0 + bj * HALF) = w;
                }
                if (vstat) {
                    s1 += __shfl_xor(s1, 16); s1 += __shfl_xor(s1, 32); s2 += __shfl_xor(s2, 16); s2 += __shfl_xor(s2, 32);
                    if (fq == 0) *(f32x2*)(E.st_out + (row * 32 + (u.pn - 8) * 4 + wc) * 2) = (f32x2){s1, s2};
                }
                asm volatile("" ::: "memory");
            }
    }
}

template <int MODE, int N, int K, int LDA, bool GROUPED, int M = MTOK>
__device__ __forceinline__ void gemm_phase(LAS unsigned char* lds, const bf16_t* gA, const bf16_t* gBt, const Epi& E, int G, int c) {
    const int tid = threadIdx.x, wid = __builtin_amdgcn_readfirstlane(tid >> 6), lane = tid & 63, wr = wid >> 2, wc = wid & 3, fr = lane & 15, fq = lane >> 4;
    constexpr int nt = K / BK, lda = LDA;
    constexpr bool RELAX = false;
    StaticOrder S; S.init(M, N, G, c);
    LAS float* rsl = (LAS float*)(lds + RS_OFF);
    unsigned voffA[2], voffB[2];
#pragma unroll
    for (int i = 0; i < 2; ++i) { int R, C; stage_rc(tid * 16 + i * 8192, R, C); const int Rb = (R & ~31) + perm32(R & 31);
        voffA[i] = (unsigned)(R * lda + C) * 2u; voffB[i] = (unsigned)(Rb * K + C) * 2u; }
    const size_t kstep = (size_t)(BK * 2);
    const size_t hstepA = (size_t)HALF * lda * 2, hstepB = (size_t)HALF * K * 2;
    const size_t tstepA = 2 * hstepA, tstepB = 2 * hstepB;
    const unsigned ldsw = (unsigned)wid * 1024u;
    const int aoff = lds_byte(wr * 64 + fr, fq * 8), boff = lds_byte(wc * 32 + fr, fq * 8);
#define PG8_SA(b, h) (((b) * 2 + (h)) * HTB)
#define PG8_SB(b, h) ((4 + (b) * 2 + (h)) * HTB)
#define PG8_STAGE(bufoff, gbase, voff) do { const char* _g = (const char*)(gbase); asm volatile("" : "+s"(_g)); _Pragma("unroll") for (int _i = 0; _i < 2; ++_i) { unsigned _v = (voff)[_i]; asm volatile("" : "+v"(_v)); \
        __builtin_amdgcn_global_load_lds((const unsigned*)(_g + _v), (LAS unsigned*)(lds + (bufoff) + ldsw + _i * 8192), 16, 0, 0); } } while (0)
#define PG8_LDA(dst, b, h) do { _Pragma("unroll") for (int m = 0; m < 4; ++m) _Pragma("unroll") for (int k = 0; k < 2; ++k) dst[m][k] = *(const LAS bf16x8*)(lds + PG8_SA(b, h) + aoff + m * 2048 + k * 1024); } while (0)
#define PG8_LDB(dst, b, h) do { _Pragma("unroll") for (int n = 0; n < 2; ++n) _Pragma("unroll") for (int k = 0; k < 2; ++k) dst[n][k] = *(const LAS bf16x8*)(lds + PG8_SB(b, h) + boff + n * 2048 + k * 1024); } while (0)
#define PG8_MMA(ai, bj, At, Bt) do { __builtin_amdgcn_s_setprio(1); _Pragma("unroll") for (int m = 0; m < 4; ++m) _Pragma("unroll") for (int n = 0; n < 2; ++n) _Pragma("unroll") for (int k = 0; k < 2; ++k) \
        acc[ai][bj][m][n] = __builtin_amdgcn_mfma_f32_16x16x32_bf16(Bt[n][k], At[m][k], acc[ai][bj][m][n], 0, 0, 0); __builtin_amdgcn_s_setprio(0); } while (0)
#define PG8_WAIT_V(n) asm volatile("s_waitcnt vmcnt(" #n ")" ::: "memory")
#define PG8_WAIT_V8_OR24(flag) asm volatile("s_cmp_lg_u32 %0, 0\n\ts_cbranch_scc1 1f\n\ts_waitcnt vmcnt(8)\n1:\n\ts_waitcnt vmcnt(24)" :: "s"(flag) : "memory", "scc")
#define PG8_WAIT_L(n) asm volatile("s_waitcnt lgkmcnt(" #n ")" ::: "memory")
#define PG8_BAR __builtin_amdgcn_s_barrier()
#define PG8_SCHED __builtin_amdgcn_sched_barrier(0)
#define UNIT_A(u) ((const char*)gA + (size_t)(u).pm * tstepA + (GROUPED ? (size_t)(((u).pn >> 1) * 512) * 2 : (size_t)0))
    Unit cur, nxt; int ui = 0;
    if (!S.next(0, cur)) return;
    f32x4 acc[2][2][4][2];
#define ACC_INIT(u) do { \
    _Pragma("unroll") for (int a_ = 0; a_ < 2; ++a_) _Pragma("unroll") for (int m_ = 0; m_ < 4; ++m_) { \
        const size_t ro_ = (size_t)((u).pm * BM + wr * 64 + fr + a_ * HALF + m_ * 16) * DM + (u).pn * BM + wc * 32 + 8 * fq; \
        _Pragma("unroll") for (int b_ = 0; b_ < 2; ++b_) { \
            if (MODE == 1) { acc[a_][b_][m_][0] = *(const f32x4*)(E.res + ro_ + b_ * HALF); acc[a_][b_][m_][1] = *(const f32x4*)(E.res + ro_ + b_ * HALF + 4); } \
            else if (MODE == 6 || MODE == 5) { const u32x4 w_ = *(const u32x4*)(E.resb + ro_ + b_ * HALF); \
                acc[a_][b_][m_][0] = (f32x4){bf_lo(w_.x), bf_hi(w_.x), bf_lo(w_.y), bf_hi(w_.y)}; acc[a_][b_][m_][1] = (f32x4){bf_lo(w_.z), bf_hi(w_.z), bf_lo(w_.w), bf_hi(w_.w)}; } \
            else { acc[a_][b_][m_][0] = (f32x4){0.f, 0.f, 0.f, 0.f}; acc[a_][b_][m_][1] = (f32x4){0.f, 0.f, 0.f, 0.f}; } } } } while (0)
    ACC_INIT(cur);
    bf16x8 At[4][2], B0[2][2], B1[2][2];
    const char* cA = UNIT_A(cur); const char* cB = (const char*)gBt + (size_t)cur.pn * tstepB;
    int slot = 0;
    PG8_STAGE(PG8_SB(0, 0), cB, voffB); PG8_STAGE(PG8_SB(0, 1), cB + hstepB, voffB); PG8_STAGE(PG8_SA(0, 0), cA, voffA); PG8_STAGE(PG8_SA(0, 1), cA + hstepA, voffA);
    PG8_STAGE(PG8_SB(1, 0), cB + kstep, voffB); PG8_STAGE(PG8_SA(1, 0), cA + kstep, voffA); PG8_STAGE(PG8_SB(1, 1), cB + hstepB + kstep, voffB);
    epi_prep<MODE>(E, cur, rsl);
    if (wr == 1) PG8_BAR;
    PG8_WAIT_V(8); PG8_BAR;
    PG8_WAIT_V(6); PG8_BAR;
    for (;;) {
        const bool has_next = S.next(ui + 1, nxt);
        const char* nA = has_next ? UNIT_A(nxt) : cA; const char* nB = has_next ? (const char*)gBt + (size_t)nxt.pn * tstepB : cB;
        for (int t = 0; t < nt; t += 2) {
            const bool last = (t == nt - 2);
            const char* a1 = cA + (size_t)(t + 1) * kstep;
            const char* a2 = last ? nA : cA + (size_t)(t + 2) * kstep; const char* b2 = last ? nB : cB + (size_t)(t + 2) * kstep;
            const char* a3 = a2 + kstep; const char* b3 = b2 + kstep;
            const int rflag = __builtin_amdgcn_readfirstlane((RELAX && t == 0 && ui > 0) ? 1 : 0);
            PG8_LDB(B0, 0, 0); PG8_LDB(B1, 0, 1); PG8_SCHED; PG8_LDA(At, 0, 0); PG8_STAGE(PG8_SA(1, 1), a1 + hstepA, voffA);
            if constexpr (RELAX) PG8_WAIT_V8_OR24(rflag); else PG8_WAIT_V(8);
            PG8_WAIT_L(0); PG8_BAR; PG8_MMA(0, 0, At, B0); PG8_MMA(0, 1, At, B1); PG8_BAR; PG8_SCHED;
            PG8_LDA(At, 0, 1); PG8_STAGE(PG8_SB(0, 0), b2, voffB); PG8_STAGE(PG8_SB(0, 1), b2 + hstepB, voffB); PG8_STAGE(PG8_SA(0, 0), a2, voffA);
            if constexpr (RELAX) PG8_WAIT_V8_OR24(rflag); else PG8_WAIT_V(8);
            PG8_WAIT_L(0); PG8_BAR; PG8_MMA(1, 0, At, B0); PG8_MMA(1, 1, At, B1); PG8_BAR; PG8_SCHED;
            PG8_LDB(B0, 1, 0); PG8_LDB(B1, 1, 1); PG8_SCHED; PG8_LDA(At, 1, 0); PG8_STAGE(PG8_SA(0, 1), a2 + hstepA, voffA);
            PG8_WAIT_V(8); PG8_WAIT_L(0); PG8_BAR; PG8_MMA(0, 0, At, B0); PG8_MMA(0, 1, At, B1); PG8_BAR; PG8_SCHED;
            PG8_LDA(At, 1, 1); PG8_STAGE(PG8_SB(1, 0), b3, voffB); PG8_STAGE(PG8_SB(1, 1), b3 + hstepB, voffB); PG8_STAGE(PG8_SA(1, 0), a3, voffA);
            PG8_WAIT_V(8); PG8_WAIT_L(0); PG8_BAR; PG8_MMA(1, 0, At, B0); PG8_MMA(1, 1, At, B1); PG8_BAR; PG8_SCHED;
        }
        if (wr == 0) PG8_BAR;
        epi_run<MODE>(E, acc, cur, wr, wc, fr, fq, rsl + slot * 256);
        if (!has_next) break;
        const bool new_panel = (nxt.pm != cur.pm);
        cur = nxt; cA = nA; cB = nB; ++ui;
        ACC_INIT(cur);
        if (new_panel) { slot ^= 1; epi_prep<MODE>(E, cur, rsl + slot * 256); }
        if (wr == 1) PG8_BAR;
    }
    PG8_WAIT_V(0);
    PG8_BAR;
#undef PG8_SA
#undef PG8_SB
#undef PG8_STAGE
#undef PG8_LDA
#undef PG8_LDB
#undef PG8_MMA
#undef PG8_WAIT_V
#undef PG8_WAIT_L
#undef PG8_WAIT_V8_OR24
#undef PG8_BAR
#undef PG8_SCHED
#undef UNIT_A
#undef ACC_INIT
}

__device__ __forceinline__ void p0_transpose_item(const float* W, const float* sc, int K, int N, bf16_t* WT, LAS float* scr, int item, int lane) {
    const int nblk = N / 64, kb = item / nblk, nb = item % nblk, k0 = 64 * kb, n0 = 64 * nb;
    const int r = lane >> 4, c16 = lane & 15;
    f32x4 v[16];
    const float* src = W + (size_t)(k0 + r) * N + n0 + 4 * c16;
#pragma unroll
    for (int i = 0; i < 16; ++i) v[i] = __builtin_nontemporal_load((const f32x4*)(src + (size_t)(4 * i) * N));
    const int c = lane & 7;
    f32x4 s0 = (f32x4){1.f, 1.f, 1.f, 1.f}, s1 = s0;
    if (sc) { s0 = *(const f32x4*)(sc + k0 + 8 * c); s1 = *(const f32x4*)(sc + k0 + 8 * c + 4); }
#pragma unroll
    for (int i = 0; i < 16; ++i) { LAS float* d = scr + (4 * i + r) * 65 + 4 * c16; d[0] = v[i].x; d[1] = v[i].y; d[2] = v[i].z; d[3] = v[i].w; }
    LDS_WAIT(); asm volatile("" ::: "memory");
#pragma unroll
    for (int j = 0; j < 8; ++j) { const int n = (lane >> 3) + 8 * j; const LAS float* s = scr + (8 * c) * 65 + n;
        u32x4 o; o.x = cvt_pk_bf16(s[0 * 65] * s0.x, s[1 * 65] * s0.y); o.y = cvt_pk_bf16(s[2 * 65] * s0.z, s[3 * 65] * s0.w);
        o.z = cvt_pk_bf16(s[4 * 65] * s1.x, s[5 * 65] * s1.y); o.w = cvt_pk_bf16(s[6 * 65] * s1.z, s[7 * 65] * s1.w);
        *(u32x4*)(WT + (size_t)(n0 + n) * K + k0 + 8 * c) = o; }
    LDS_WAIT(); asm volatile("" ::: "memory");
}

__device__ __forceinline__ void p0_phase(LAS unsigned char* lds, const Args& a, const bool skip_l1mlp) {
    const int tid = threadIdx.x, wave = __builtin_amdgcn_readfirstlane(tid >> 6), lane = tid & 63;
    LAS float* scr = (LAS float*)(lds + wave * 16640);
    const int gw = blockIdx.x * 8 + wave, NGW = gridDim.x * 8;
    unsigned char* ws = a.ws;
    constexpr int I_AIN = 32 * 64, I_SQ = 32 * 32, I_W1 = 32 * 128, I_W2 = 128 * 32, I_GRP = 8 * 8;
    constexpr int NITEMS = I_AIN + 3 * I_SQ + 2 * I_W1 + 2 * I_W2;
    for (int it = gw; it < NITEMS; it += NGW) {
        int r = it;
        if (r < I_W1) { if (!skip_l1mlp) p0_transpose_item(a.mlp_w1, a.norm_mlp, DM, FF, (bf16_t*)(ws + WS_WT_W1_0), scr, r, lane); continue; } r -= I_W1;
        if (r < I_W1) { if (!skip_l1mlp) p0_transpose_item(a.mlp_w1 + (size_t)DM * FF, a.norm_mlp + DM, DM, FF, (bf16_t*)(ws + WS_WT_W1_1), scr, r, lane); continue; } r -= I_W1;
        if (r < I_W2) { if (!skip_l1mlp) p0_transpose_item(a.mlp_w2, nullptr, FF, DM, (bf16_t*)(ws + WS_WT_W2_0), scr, r, lane); continue; } r -= I_W2;
        if (r < I_W2) { if (!skip_l1mlp) p0_transpose_item(a.mlp_w2 + (size_t)DM * FF, nullptr, FF, DM, (bf16_t*)(ws + WS_WT_W2_1), scr, r, lane); continue; } r -= I_W2;
        if (r < I_AIN) { p0_transpose_item(a.a_w_in, a.norm_mix, DM, 4096, (bf16_t*)(ws + WS_WT_AIN), scr, r, lane); continue; } r -= I_AIN;
        if (r < I_SQ) { p0_transpose_item(a.a_w_out, nullptr, DM, DM, (bf16_t*)(ws + WS_WT_AOUT), scr, r, lane); continue; } r -= I_SQ;
        if (r < I_SQ) { p0_transpose_item(a.b_w_in, a.norm_mix + DM, DM, DM, (bf16_t*)(ws + WS_WT_BIN), scr, r, lane); continue; } r -= I_SQ;
        p0_transpose_item(a.b_w_out, a.b_scale, DM, DM, (bf16_t*)(ws + WS_WT_BOUT), scr, r, lane);
    }
    for (int it = gw; it < 2048; it += NGW) {
        const f32x4* sp = (const f32x4*)(a.b_w_grp + (size_t)it * 512) + 2 * lane; const f32x4 p = sp[0], q = sp[1];
        u32x4 o; o.x = cvt_pk_bf16(p.x, p.y); o.y = cvt_pk_bf16(p.z, p.w); o.z = cvt_pk_bf16(q.x, q.y); o.w = cvt_pk_bf16(q.z, q.w);
        *((u32x4*)((bf16_t*)(ws + WS_WT_GRP) + (size_t)it * 512) + lane) = o;
    }
    bf16_t* XB = (bf16_t*)(ws + WS_HB); float* XST = (float*)(ws + WS_XST);
    for (int m = gw; m < MTOK; m += NGW) {
        const f32x4* xr = (const f32x4*)(a.x + (size_t)m * DM) + lane;
        f32x4 v[8]; float s = 0.f;
#pragma unroll
        for (int j = 0; j < 8; ++j) { v[j] = __builtin_nontemporal_load(xr + 64 * j); s += (v[j].x * v[j].x + v[j].y * v[j].y) + (v[j].z * v[j].z + v[j].w * v[j].w); }
        s = wave_sum(s);
        u32x2* o8 = (u32x2*)(XB + (size_t)m * DM) + lane;
#pragma unroll
        for (int j = 0; j < 8; ++j) { u32x2 w; w.x = cvt_pk_bf16(v[j].x, v[j].y); w.y = cvt_pk_bf16(v[j].z, v[j].w); o8[64 * j] = w; }
        if (lane < 32) XST[(size_t)m * 32 + lane] = (lane == 0) ? s : 0.f;
    }
}

__device__ __forceinline__ void spatial_phase(LAS unsigned char* lds, const Args& a, int first, int stride) {
    const int tid = threadIdx.x, wid = __builtin_amdgcn_readfirstlane(tid >> 6), lane = tid & 63, fr = lane & 15, fq = lane >> 4;
    LAS unsigned* VT = (LAS unsigned*)lds;
    LAS unsigned char* WL = lds + 69632;
    LAS float* MR = (LAS float*)(lds + 104448);
    const bf16_t* Z = (const bf16_t*)(a.ws + WS_ACT);
    bf16_t* GATED = (bf16_t*)(a.ws + WS_ACT + (size_t)MTOK * 4096 * 2);
    const float* VST = (const float*)(a.ws + WS_VST);
    for (int it = first; it < 512; it += stride) {
        const int g = it & 7, tok0 = (it >> 3) * 128;
        if (tid < 256) {
            const int row = tid >> 1, half = tid & 1;
            const f32x4* p = (const f32x4*)(VST + ((size_t)(tok0 + row) * 32 + half * 16) * 2);
            float s1 = 0.f, s2 = 0.f;
#pragma unroll
            for (int j = 0; j < 8; ++j) { const f32x4 q = p[j]; s1 += q.x + q.z; s2 += q.y + q.w; }
            s1 += __shfl_xor(s1, 1); s2 += __shfl_xor(s2, 1);
            const float mean = s1 * (1.0f / 2048.0f), var = s2 * (1.0f / 2048.0f) - mean * mean;
            if (!half) { MR[row] = mean; MR[128 + row] = __builtin_amdgcn_rsqf(var + EPS); }
        }
        const float* Wg = a.a_w_s + (size_t)g * 16384;
#pragma unroll
        for (int i = 0; i < 8; ++i) {
            const int idx = (i * 512 + tid) * 4, t = idx >> 7, s = idx & 127;
            f32x4 w = *(const f32x4*)(Wg + idx);
            w.x = (s <= t) ? w.x : 0.f; w.y = (s + 1 <= t) ? w.y : 0.f; w.z = (s + 2 <= t) ? w.z : 0.f; w.w = (s + 3 <= t) ? w.w : 0.f;
            u32x2 o; o.x = cvt_pk_bf16(w.x, w.y); o.y = cvt_pk_bf16(w.z, w.w);
            *(LAS u32x2*)(WL + (t * 136 + s) * 2) = o;
        }
        __syncthreads();
        {
            const float m0 = MR[2 * lane], m1 = MR[2 * lane + 1], r0 = MR[128 + 2 * lane], r1 = MR[128 + 2 * lane + 1];
#pragma unroll
            for (int pass = 0; pass < 4; ++pass) {
                const int d0 = (wid + 8 * pass) * 8;
                const bf16_t* zp = Z + (size_t)(tok0 + 2 * lane) * 4096 + 2048 + g * 256 + d0;
                const u32x4 va = *(const u32x4*)zp, vb = *(const u32x4*)(zp + 4096);
                const f32x4 g0 = *(const f32x4*)(a.a_ln_g + g * 256 + d0), g1 = *(const f32x4*)(a.a_ln_g + g * 256 + d0 + 4);
                const f32x4 b0 = *(const f32x4*)(a.a_ln_b + g * 256 + d0), b1 = *(const f32x4*)(a.a_ln_b + g * 256 + d0 + 4);
                const float gg[8] = {g0.x, g0.y, g0.z, g0.w, g1.x, g1.y, g1.z, g1.w}, bb[8] = {b0.x, b0.y, b0.z, b0.w, b1.x, b1.y, b1.z, b1.w};
#pragma unroll
                for (int i = 0; i < 8; ++i) {
                    const unsigned wa = va[i >> 1], wb = vb[i >> 1];
                    const float x0 = (i & 1) ? bf_hi(wa) : bf_lo(wa), x1 = (i & 1) ? bf_hi(wb) : bf_lo(wb);
                    const float y0 = (x0 - m0) * r0 * gg[i] + bb[i], y1 = (x1 - m1) * r1 * gg[i] + bb[i];
                    VT[(d0 + i) * 68 + lane] = cvt_pk_bf16(y0, y1);
                }
            }
        }
        __syncthreads();
        f32x4 acc[8][2];
#pragma unroll
        for (int mt = 0; mt < 8; ++mt) { acc[mt][0] = (f32x4){0.f, 0.f, 0.f, 0.f}; acc[mt][1] = (f32x4){0.f, 0.f, 0.f, 0.f}; }
        bf16x8 X[2][4];
#pragma unroll
        for (int nd = 0; nd < 2; ++nd)
#pragma unroll
            for (int kk = 0; kk < 4; ++kk) X[nd][kk] = *(const LAS bf16x8*)(lds + ((32 * wid + 16 * nd + fr) * 136 + 32 * kk + 8 * fq) * 2);
#pragma unroll
        for (int mt = 0; mt < 8; ++mt)
#pragma unroll
            for (int kk = 0; kk < 4; ++kk)
                if (32 * kk <= 16 * mt + 15) {
                    const bf16x8 Y = *(const LAS bf16x8*)(WL + ((16 * mt + fr) * 136 + 32 * kk + 8 * fq) * 2);
                    acc[mt][0] = __builtin_amdgcn_mfma_f32_16x16x32_bf16(X[0][kk], Y, acc[mt][0], 0, 0, 0);
                    acc[mt][1] = __builtin_amdgcn_mfma_f32_16x16x32_bf16(X[1][kk], Y, acc[mt][1], 0, 0, 0);
                }
#pragma unroll
        for (int mt = 0; mt < 8; ++mt) {
            const int t = 16 * mt + fr; const float bias = a.a_b_s[g * 128 + t];
#pragma unroll
            for (int nd = 0; nd < 2; ++nd) {
                const int d = 32 * wid + 16 * nd + 4 * fq;
                const u32x2 uu = *(const u32x2*)(Z + (size_t)(tok0 + t) * 4096 + g * 256 + d);
                const f32x4 sv = acc[mt][nd] + bias;
                u32x2 o; o.x = cvt_pk_bf16(sv.x * bf_lo(uu.x), sv.y * bf_hi(uu.x)); o.y = cvt_pk_bf16(sv.z * bf_lo(uu.y), sv.w * bf_hi(uu.y));
                *(u32x2*)(GATED + (size_t)(tok0 + t) * DM + g * 256 + d) = o;
            }
        }
        __syncthreads();
    }
}

__device__ __forceinline__ void unpack8(const u32x4 w, float (&f)[8]) {
    f[0] = bf_lo(w.x); f[1] = bf_hi(w.x); f[2] = bf_lo(w.y); f[3] = bf_hi(w.y); f[4] = bf_lo(w.z); f[5] = bf_hi(w.z); f[6] = bf_lo(w.w); f[7] = bf_hi(w.w);
}
template <int W>
__device__ __forceinline__ void pool_run(const bf16_t* vp, bf16_t* pp, int p0) {
    u32x4 raw[W + 15];
#pragma unroll
    for (int j = 0; j < W + 15; ++j) { const int row = j - (W - 1);
        raw[j] = (row >= 0 || p0 > 0) ? *(const u32x4*)(vp + (ptrdiff_t)row * DM) : (u32x4){0u, 0u, 0u, 0u}; }
    float sum[8];
#pragma unroll
    for (int k = 0; k < 8; ++k) sum[k] = 0.f;
#pragma unroll
    for (int j = 0; j < W - 1; ++j) { float f[8]; unpack8(raw[j], f);
#pragma unroll
        for (int k = 0; k < 8; ++k) sum[k] += f[k]; }
#pragma unroll
    for (int i = 0; i < 16; ++i) {
        const int p = p0 + i; float c[8], f[8]; unpack8(raw[W - 1 + i], c); unpack8(raw[i], f);
        const int cnt = (p + 1 < W) ? (p + 1) : W; const float inv = 1.0f / (float)cnt;
        float o[8];
#pragma unroll
        for (int k = 0; k < 8; ++k) { sum[k] += c[k]; o[k] = sum[k] * inv - c[k]; sum[k] -= f[k]; }
        u32x4 ov; ov.x = cvt_pk_bf16(o[0], o[1]); ov.y = cvt_pk_bf16(o[2], o[3]); ov.z = cvt_pk_bf16(o[4], o[5]); ov.w = cvt_pk_bf16(o[6], o[7]);
        *(u32x4*)(pp + (size_t)i * DM) = ov;
    }
}
__device__ __forceinline__ void pool_phase(const Args& a, int first_blk, int nblk) {
    const bf16_t* V = (const bf16_t*)(a.ws + WS_ACT);
    bf16_t* P = (bf16_t*)(a.ws + WS_ACT + (size_t)MTOK * DM * 2);
    for (int gid = first_blk * 512 + (int)threadIdx.x; gid < (MTOK / 16) * 256; gid += nblk * 512) {
        const int cc = gid & 255, t0 = (gid >> 8) * 16, p0 = t0 & (SEQ - 1);
        const int grp = __builtin_amdgcn_readfirstlane(cc >> 6);
        const bf16_t* vp = V + (size_t)t0 * DM + cc * 8; bf16_t* pp = P + (size_t)t0 * DM + cc * 8;
        if (grp == 0) pool_run<2>(vp, pp, p0); else if (grp == 1) pool_run<4>(vp, pp, p0); else if (grp == 2) pool_run<8>(vp, pp, p0); else pool_run<16>(vp, pp, p0);
    }
}

__device__ __forceinline__ void final_phase(const Args& a) {
    const int tid = threadIdx.x, wave = tid >> 6, lane = tid & 63;
    const float* HST = (const float*)(a.ws + WS_HST4);
    for (int m = blockIdx.x * 8 + wave; m < MTOK; m += gridDim.x * 8) {
        float s = (lane < 32) ? HST[(size_t)m * 32 + lane] : 0.f;
        s = wave_sum(s);
        const float r = __builtin_amdgcn_rsqf(s * (1.0f / DM) + EPS);
        f32x4* op = (f32x4*)(a.out + (size_t)m * DM) + lane; const f32x4* gp = (const f32x4*)a.final_norm + lane;
#pragma unroll
        for (int j = 0; j < 8; ++j) { const f32x4 v = op[64 * j], gg = gp[64 * j]; op[64 * j] = v * r * gg; }
    }
}

#define XB_TMO      128
#define XB_XCNT(j)  (256  + 64 * (j))
#define XB_XSUB(j)  (1280 + 64 * (j))
#define XB_XGEN(j)  (2304 + 64 * (j))
#define XB_TOP      3328
#define XB_TOPGEN   3392
#define XCD_BAR_WORDS 3456
#define XB_SPIN_CAP (1u << 18)
__device__ __forceinline__ unsigned xb_ld(unsigned* p)              { return __hip_atomic_load(p, __ATOMIC_RELAXED, __HIP_MEMORY_SCOPE_AGENT); }
__device__ __forceinline__ unsigned xb_add(unsigned* p, unsigned v) { return __hip_atomic_fetch_add(p, v, __ATOMIC_RELAXED, __HIP_MEMORY_SCOPE_AGENT); }
__device__ __forceinline__ unsigned xb_xcc_id() { return (unsigned)__builtin_amdgcn_s_getreg((3 << 11) | 20) & 0xFu; }
#define XB_SPIN(cond, bar) do { unsigned _sp = 0; while (cond) { __builtin_amdgcn_s_sleep(1); \
    if ((++_sp & 255u) == 0u) { if (xb_ld(&(bar)[XB_TMO])) break; if (_sp > XB_SPIN_CAP) { atomicAdd(&(bar)[XB_TMO], 1u); break; } } } } while (0)
struct XcdBarrier { unsigned* bar; unsigned x; volatile LAS unsigned* st; };
__device__ __forceinline__ XcdBarrier xcd_barrier_post(unsigned* bar, volatile LAS unsigned* st) {
    XcdBarrier b; b.bar = bar; b.x = xb_xcc_id(); b.st = st;
    if (threadIdx.x == 0) (void)xb_add(&bar[XB_XCNT(b.x)], 1u);
    return b;
}
__device__ __forceinline__ void xcd_barrier_complete(unsigned* bar, unsigned x, unsigned& nloc, unsigned& nx) {
    const unsigned G = gridDim.x * gridDim.y * gridDim.z;
    unsigned sum, cnt, mine, sp = 0u;
    for (;;) {
        sum = 0u; cnt = 0u; mine = 0u;
#pragma unroll
        for (unsigned j = 0; j < 16; ++j) { const unsigned c = xb_ld(&bar[XB_XCNT(j)]); sum += c; cnt += (c > 0u) ? 1u : 0u; mine = (j == x) ? c : mine; }
        if (sum == G) break;
        __builtin_amdgcn_s_sleep(1);
        if ((++sp & 255u) == 0u) { if (xb_ld(&bar[XB_TMO])) break; if (sp > XB_SPIN_CAP) { atomicAdd(&bar[XB_TMO], 1u); break; } }
    }
    nloc = mine > 0u ? mine : 1u; nx = cnt > 0u ? cnt : 1u;
}
__device__ __forceinline__ void seam_convert(LAS unsigned char* lds, const Args& a, int batch) {
    const int tid = threadIdx.x, wave = __builtin_amdgcn_readfirstlane(tid >> 6), lane = tid & 63;
    if (wave >= 1 && wave <= 4) {
        LAS float* scr = (LAS float*)(lds + wave * 16640);
        const int base = (batch & 3) * 1024;
        for (int it = base + (int)blockIdx.x * 4 + (wave - 1); it < base + 1024; it += (int)gridDim.x * 4) {
            if (batch < 4) p0_transpose_item(a.mlp_w1 + (size_t)DM * FF, a.norm_mlp + DM, DM, FF, (bf16_t*)(a.ws + WS_WT_W1_1), scr, it, lane);
            else p0_transpose_item(a.mlp_w2 + (size_t)DM * FF, nullptr, FF, DM, (bf16_t*)(a.ws + WS_WT_W2_1), scr, it, lane);
        }
    }
}
__device__ __forceinline__ void seam_warm(LAS unsigned char* lds, const bf16_t* p, int wave_lo, const bool skip_last_quarter) {
    const int tid = threadIdx.x, wave = __builtin_amdgcn_readfirstlane(tid >> 6), lane = tid & 63;
    if (wave >= wave_lo) {
        const int nw = 8 - wave_lo;
        const char* base = (const char*)p + lane * 16;
        for (int i = (int)blockIdx.x * nw + (wave - wave_lo); i < 32768; i += (int)gridDim.x * nw)
            if (!(skip_last_quarter && (i & 15) >= 12)) __builtin_amdgcn_global_load_lds((const unsigned*)(base + (size_t)i * 1024), (LAS unsigned*)(lds + 98304 + wave * 1024), 16, 0, 0);
        asm volatile("s_waitcnt vmcnt(0)" ::: "memory");
    }
}
template <bool CONV>
__device__ __forceinline__ void xcd_barrier_t(const XcdBarrier& b, LAS unsigned char* lds, const Args& a, int batch, const bf16_t* warm = nullptr, int warm_lo = 8, const bool warm_skipq = false) {
    asm volatile("s_waitcnt vmcnt(0)" ::: "memory");
    __syncthreads();
    if (threadIdx.x == 0) {
        unsigned* bar = b.bar;
        __builtin_amdgcn_s_waitcnt(0);
        unsigned nloc = b.st[0], nx = b.st[1];
        if (nloc == 0u) { xcd_barrier_complete(bar, b.x, nloc, nx); b.st[0] = nloc; b.st[1] = nx; }
        const unsigned old = xb_add(&bar[XB_XSUB(b.x)], 1u);
        const unsigned gen = old / nloc;
        if (old + 1u == (gen + 1u) * nloc) {
            __builtin_amdgcn_fence(__ATOMIC_RELEASE, "agent");
            asm volatile("s_waitcnt vmcnt(0)" ::: "memory");
            const unsigned og = xb_add(&bar[XB_TOP], 1u);
            const unsigned tg = og / nx;
            if (og + 1u == (tg + 1u) * nx) xb_add(&bar[XB_TOPGEN], 1u);
            else XB_SPIN(xb_ld(&bar[XB_TOPGEN]) == tg, bar);
            __builtin_amdgcn_fence(__ATOMIC_ACQUIRE, "agent");
            asm volatile("s_waitcnt vmcnt(0)" ::: "memory");
        } else {
            XB_SPIN(xb_ld(&bar[XB_TOPGEN]) == gen, bar);
            __builtin_amdgcn_fence(__ATOMIC_ACQUIRE, "agent");
            asm volatile("s_waitcnt vmcnt(0)" ::: "memory");
        }
    }
    if constexpr (CONV) seam_convert(lds, a, batch);
    if (warm) seam_warm(lds, warm, warm_lo, warm_skipq);
    __syncthreads();
}
__device__ __forceinline__ void xcd_barrier(const XcdBarrier& b, LAS unsigned char* lds, const Args& a) { xcd_barrier_t<false>(b, lds, a, -1); }

__device__ __forceinline__ void jit_convert(LAS unsigned char* lds, const float* W, const float* sc, int K, int N, bf16_t* WT) {
    const int tid = threadIdx.x, wave = __builtin_amdgcn_readfirstlane(tid >> 6), lane = tid & 63;
    LAS float* scr = (LAS float*)(lds + wave * 16640);
    for (int it = (int)blockIdx.x * 8 + wave; it < 4096; it += (int)gridDim.x * 8) p0_transpose_item(W, sc, K, N, WT, scr, it, lane);
}

__global__ void __launch_bounds__(512, 2) mega_fwd(Args a) {
    extern __shared__ __attribute__((aligned(16))) unsigned char lds_raw[];
    LAS unsigned char* lds = (LAS unsigned char*)lds_raw;
    cg::grid_group grid = cg::this_grid();
    unsigned char* ws = a.ws;
    const int lo = a.ph_lo, hi = a.ph_hi;
#define IN(k) (lo <= (k) && (k) < hi)
    const bool multi = (hi - lo) > 1, use_cg = hi > 64;
    volatile LAS unsigned* xst = (volatile LAS unsigned*)(lds + XB_ST_OFF);
    if (threadIdx.x < 2) xst[threadIdx.x] = 0u;
    __syncthreads();
    XcdBarrier bar; bar.bar = (unsigned*)(ws + WS_BAR); bar.x = 0; bar.st = xst;
    if (multi && !use_cg) bar = xcd_barrier_post((unsigned*)(ws + WS_BAR), xst);
    const bool seamconv = multi && !use_cg && IN(0) && IN(11);
#define SEAM_BATCH(k) ((k) == 1 ? 0 : (k) == 2 ? 1 : (k) == 3 ? 2 : (k) == 4 ? 3 : (k) == 5 ? 4 : (k) == 6 ? 5 : (k) == 7 ? 6 : (k) == 9 ? 7 : -1)
#define SEAM(k) do { if (IN(k) && ((k) == 7 ? IN(9) : IN((k) + 1))) { if (use_cg) grid.sync(); else if (seamconv && SEAM_BATCH(k) >= 0) xcd_barrier_t<true>(bar, lds, a, SEAM_BATCH(k)); else xcd_barrier(bar, lds, a); } } while (0)
    bf16_t* HB = (bf16_t*)(ws + WS_HB); bf16_t* ACT = (bf16_t*)(ws + WS_ACT);
    if (IN(0)) p0_phase(lds, a, seamconv);
#if DUP_PHASE == 0
    if (IN(0)) p0_phase(lds, a, seamconv);
#endif
    if (seamconv) xcd_barrier_t<true>(bar, lds, a, 7);
    else SEAM(0);
    if (IN(1)) { Epi E{0, ACT, 4096, nullptr, nullptr, (float*)(ws + WS_VST), (const float*)(ws + WS_XST)};
        gemm_phase<0, 4096, 2048, 2048, false>(lds, HB, (const bf16_t*)(ws + WS_WT_AIN), E, (int)gridDim.x, (int)blockIdx.x); }
#if DUP_PHASE == 1
    if (IN(1)) { Epi E{0, ACT, 4096, nullptr, nullptr, (float*)(ws + WS_VST), (const float*)(ws + WS_XST)};
        gemm_phase<0, 4096, 2048, 2048, false>(lds, HB, (const bf16_t*)(ws + WS_WT_AIN), E, (int)gridDim.x, (int)blockIdx.x); }
#endif
    SEAM(1);
    if (IN(2)) spatial_phase(lds, a, (int)blockIdx.x, (int)gridDim.x);
    SEAM(2);
    if (IN(3)) { Epi E{6, HB, DM, nullptr, nullptr, (float*)(ws + WS_HST1), nullptr, nullptr, nullptr, HB};
        gemm_phase<6, 2048, 2048, 2048, false>(lds, ACT + (size_t)MTOK * 4096, (const bf16_t*)(ws + WS_WT_AOUT), E, (int)gridDim.x, (int)blockIdx.x); }
    if (seamconv) jit_convert(lds, a.mlp_w1, a.norm_mlp, DM, FF, (bf16_t*)(ws + WS_WT_W1_0));
    SEAM(3);
    if (IN(4)) { Epi E{2, ACT, FF, nullptr, nullptr, nullptr, (const float*)(ws + WS_HST1)};
        gemm_phase<2, 8192, 2048, 2048, false>(lds, HB, (const bf16_t*)(ws + WS_WT_W1_0), E, (int)gridDim.x, (int)blockIdx.x); }
#if DUP_PHASE == 4
    if (IN(4)) { Epi E{2, ACT, FF, nullptr, nullptr, nullptr, (const float*)(ws + WS_HST1)};
        gemm_phase<2, 8192, 2048, 2048, false>(lds, HB, (const bf16_t*)(ws + WS_WT_W1_0), E, (int)gridDim.x, (int)blockIdx.x); }
#endif
    if (seamconv) jit_convert(lds, a.mlp_w2, nullptr, FF, DM, (bf16_t*)(ws + WS_WT_W2_0));
    SEAM(4);
    if (IN(5)) { Epi E{6, HB, DM, nullptr, nullptr, (float*)(ws + WS_HST2), nullptr, nullptr, nullptr, HB};
        gemm_phase<6, 2048, 8192, 8192, false>(lds, ACT, (const bf16_t*)(ws + WS_WT_W2_0), E, (int)gridDim.x, (int)blockIdx.x); }
    SEAM(5);
    if (IN(6)) { Epi E{3, ACT, DM, nullptr, nullptr, nullptr, (const float*)(ws + WS_HST2)};
        gemm_phase<3, 2048, 2048, 2048, false>(lds, HB, (const bf16_t*)(ws + WS_WT_BIN), E, (int)gridDim.x, (int)blockIdx.x); }
#if DUP_PHASE == 6
    if (IN(6)) { Epi E{3, ACT, DM, nullptr, nullptr, nullptr, (const float*)(ws + WS_HST2)};
        gemm_phase<3, 2048, 2048, 2048, false>(lds, HB, (const bf16_t*)(ws + WS_WT_BIN), E, (int)gridDim.x, (int)blockIdx.x); }
#endif
    SEAM(6);
    if (IN(7)) {
        const bool split = gridDim.x >= 128;
        const int gwc = split ? 64 : (int)gridDim.x;
        if ((int)blockIdx.x < gwc) { Epi E{4, (bf16_t*)(ws + WS_WCT), DM, nullptr, nullptr, nullptr, nullptr};
            gemm_phase<4, 2048, 512, 2048, true, 2048>(lds, (const bf16_t*)(ws + WS_WT_BOUT), (const bf16_t*)(ws + WS_WT_GRP), E, gwc, (int)blockIdx.x); }
        if (split) { if (blockIdx.x >= 64) pool_phase(a, (int)blockIdx.x - 64, (int)gridDim.x - 64); }
        else pool_phase(a, (int)blockIdx.x, (int)gridDim.x);
    }
    SEAM(7);
    if (IN(9)) { Epi E{6, HB, DM, nullptr, nullptr, (float*)(ws + WS_HST3), nullptr, nullptr, nullptr, HB};
        gemm_phase<6, 2048, 2048, 2048, false>(lds, ACT + (size_t)MTOK * DM, (const bf16_t*)(ws + WS_WCT), E, (int)gridDim.x, (int)blockIdx.x); }
    if (seamconv) { if (IN(9) && IN(10)) xcd_barrier_t<false>(bar, lds, a, -1, (const bf16_t*)(ws + WS_WT_W1_1), 1); }
    else SEAM(9);
    if (IN(10)) { Epi E{2, ACT, FF, nullptr, nullptr, nullptr, (const float*)(ws + WS_HST3)};
        gemm_phase<2, 8192, 2048, 2048, false>(lds, HB, (const bf16_t*)(ws + WS_WT_W1_1), E, (int)gridDim.x, (int)blockIdx.x); }
    if (seamconv) { if (IN(10) && IN(11)) xcd_barrier_t<false>(bar, lds, a, -1, (const bf16_t*)(ws + WS_WT_W2_1), 1); }
    else SEAM(10);
#if FUSE_FINAL
    if (IN(11)) { Epi E{5, nullptr, DM, a.out, nullptr, (float*)(ws + WS_HST4), nullptr, (unsigned*)(ws + WS_BAR + 16384), a.final_norm, HB};
        gemm_phase<5, 2048, 8192, 8192, false>(lds, ACT, (const bf16_t*)(ws + WS_WT_W2_1), E, (int)gridDim.x, (int)blockIdx.x); }
#else
    if (IN(11)) { Epi E{1, nullptr, DM, a.out, a.out, (float*)(ws + WS_HST4), nullptr};
        gemm_phase<1, 2048, 8192, 8192, false>(lds, ACT, (const bf16_t*)(ws + WS_WT_W2_1), E, (int)gridDim.x, (int)blockIdx.x); }
    SEAM(11);
    if (IN(12)) final_phase(a);
#endif
#undef IN
#undef SEAM
}

extern "C" void kernel_launch(void* const* d_in, const int* in_sizes, int n_in, void* d_out, int out_size, void* d_ws, size_t ws_size, hipStream_t stream) {
    static int grid = 0;
    if (grid == 0) {
        if (n_in != 16 || out_size != MTOK * DM || ws_size < WS_END) { fprintf(stderr, "kernel_launch: unexpected shapes (n_in %d out %d ws %zu need %zu)\n", n_in, out_size, ws_size, (size_t)WS_END); grid = -1; return; }
        int dev = 0, cus = 0, per_cu = 0;
        hipGetDevice(&dev);
        hipDeviceGetAttribute(&cus, hipDeviceAttributeMultiprocessorCount, dev);
        hipFuncSetAttribute((const void*)mega_fwd, hipFuncAttributeMaxDynamicSharedMemorySize, LDS_BYTES);
        hipOccupancyMaxActiveBlocksPerMultiprocessor(&per_cu, (const void*)mega_fwd, 512, LDS_BYTES);
        if (per_cu < 1) { fprintf(stderr, "kernel_launch: occupancy query reports %d blocks per CU\n", per_cu); per_cu = 1; }
        (void)hipGetLastError();
        grid = cus * 1;
    }
    if (grid < 0) return;
    Args a{};
    a.x = (const float*)d_in[0]; a.a_w_in = (const float*)d_in[1]; a.a_ln_g = (const float*)d_in[2]; a.a_ln_b = (const float*)d_in[3]; a.a_w_s = (const float*)d_in[4];
    a.a_b_s = (const float*)d_in[5]; a.a_w_out = (const float*)d_in[6]; a.b_w_in = (const float*)d_in[7]; a.b_w_grp = (const float*)d_in[8]; a.b_scale = (const float*)d_in[9];
    a.b_w_out = (const float*)d_in[10]; a.norm_mix = (const float*)d_in[11]; a.norm_mlp = (const float*)d_in[12]; a.mlp_w1 = (const float*)d_in[13]; a.mlp_w2 = (const float*)d_in[14];
    a.final_norm = (const float*)d_in[15]; a.out = (float*)d_out; a.ws = (unsigned char*)d_ws;
#if N_LAUNCH_MODE == 1
    a.ph_lo = 0; a.ph_hi = 13;
    if (hipMemsetAsync((unsigned char*)d_ws + WS_BAR, 0, 32768, stream) != hipSuccess) { fprintf(stderr, "kernel_launch: memset of the barrier words failed\n"); return; }
    void* args[] = {&a};
    hipError_t e = hipLaunchCooperativeKernel((const void*)mega_fwd, dim3(grid), dim3(512), args, LDS_BYTES, stream);
    if (e != hipSuccess) fprintf(stderr, "cooperative launch failed: %s (grid %d)\n", hipGetErrorString(e), grid);
#else
    for (int ph = 0; ph < 13; ++ph) { a.ph_lo = ph; a.ph_hi = ph + 1; hipLaunchKernelGGL(mega_fwd, dim3(grid), dim3(512), LDS_BYTES, stream, a); }
#endif
}
```

```cpp
#include <hip/hip_runtime.h>
#include <hip/hip_cooperative_groups.h>
#include <cstdio>
#include <cstdint>
namespace cg = cooperative_groups;

#define LAS __attribute__((address_space(3)))
typedef unsigned short bf16_t;
typedef short bf16x8 __attribute__((ext_vector_type(8)));
typedef float f32x4 __attribute__((ext_vector_type(4)));
typedef float f32x2 __attribute__((ext_vector_type(2)));
typedef unsigned u32x4 __attribute__((ext_vector_type(4)));
typedef unsigned u32x2 __attribute__((ext_vector_type(2)));

constexpr int MTOK = 8192, DM = 2048, FF = 8192, SEQ = 2048;
constexpr float EPS = 1e-6f;
constexpr int BM = 256, BK = 64, HALF = 128, HTB = HALF * BK * 2, STAGE_BYTES = 8 * HTB, NXCD = 8, WGM = 8;
constexpr int RS_OFF = STAGE_BYTES;
constexpr int XB_ST_OFF = STAGE_BYTES + 2048;
constexpr int LDS_BYTES = STAGE_BYTES + 2048 + 16;

#ifndef DUP_PHASE
#define DUP_PHASE -1
#endif
#define REP(k) ((DUP_PHASE == (k)) ? 2 : 1)
#ifndef FUSE_FINAL
#define FUSE_FINAL 1
#endif
#ifndef N_LAUNCH_MODE
#define N_LAUNCH_MODE 1
#endif

constexpr size_t WS_WT_AIN = 0;
constexpr size_t WS_WT_AOUT = WS_WT_AIN + (size_t)4096 * 2048 * 2;
constexpr size_t WS_WT_W1_0 = WS_WT_AOUT + (size_t)2048 * 2048 * 2;
constexpr size_t WS_WT_W2_0 = WS_WT_W1_0 + (size_t)8192 * 2048 * 2;
constexpr size_t WS_WT_BIN = WS_WT_W2_0 + (size_t)8192 * 2048 * 2;
constexpr size_t WS_WT_GRP = WS_WT_BIN + (size_t)2048 * 2048 * 2;
constexpr size_t WS_WT_BOUT = WS_WT_GRP + (size_t)2048 * 512 * 2;
constexpr size_t WS_WT_W1_1 = WS_WT_BOUT + (size_t)2048 * 2048 * 2;
constexpr size_t WS_WT_W2_1 = WS_WT_W1_1 + (size_t)8192 * 2048 * 2;
constexpr size_t WS_HB = WS_WT_W2_1 + (size_t)8192 * 2048 * 2;
constexpr size_t WS_ACT = WS_HB + (size_t)MTOK * DM * 2;
constexpr size_t WS_XST = WS_ACT + (size_t)MTOK * FF * 2;
constexpr size_t WS_HST1 = WS_XST + (size_t)MTOK * 32 * 4;
constexpr size_t WS_HST2 = WS_HST1 + (size_t)MTOK * 32 * 4;
constexpr size_t WS_HST3 = WS_HST2 + (size_t)MTOK * 32 * 4;
constexpr size_t WS_HST4 = WS_HST3 + (size_t)MTOK * 32 * 4;
constexpr size_t WS_VST = WS_HST4 + (size_t)MTOK * 32 * 4;
constexpr size_t WS_BAR = WS_VST + (size_t)MTOK * 32 * 8;
constexpr size_t WS_WCT = WS_BAR + 32768;
constexpr size_t WS_END = WS_WCT + (size_t)2048 * 2048 * 2;

struct Args {
    const float* x; const float* a_w_in; const float* a_ln_g; const float* a_ln_b; const float* a_w_s; const float* a_b_s; const float* a_w_out;
    const float* b_w_in; const float* b_w_grp; const float* b_scale; const float* b_w_out;
    const float* norm_mix; const float* norm_mlp; const float* mlp_w1; const float* mlp_w2; const float* final_norm;
    float* out; unsigned char* ws; int ph_lo, ph_hi;
};

__device__ __forceinline__ unsigned cvt_pk_bf16(float lo, float hi) { unsigned r; asm volatile("v_cvt_pk_bf16_f32 %0, %1, %2" : "=v"(r) : "v"(lo), "v"(hi)); return r; }
__device__ __forceinline__ float bf_lo(unsigned w) { return __uint_as_float(w << 16); }
__device__ __forceinline__ float bf_hi(unsigned w) { return __uint_as_float(w & 0xffff0000u); }
__device__ __forceinline__ float wave_sum(float v) {
#pragma unroll
    for (int o = 1; o < 64; o <<= 1) v += __shfl_xor(v, o);
    return v;
}
#define LDS_WAIT() asm volatile("s_waitcnt lgkmcnt(0)" ::: "memory")

__device__ __forceinline__ f32x2 gelu_pk(f32x2 v) {
    const f32x2 av = __builtin_elementwise_abs(v), d = av * 0.2316418882f + 1.0f;
    f32x2 t; t.x = __builtin_amdgcn_rcpf(d.x); t.y = __builtin_amdgcn_rcpf(d.y);
    f32x2 q = t * 0.5307027145f + (-0.7265760135f); q = q * t + 0.7107068705f; q = q * t + (-0.142248368f); q = q * t + 0.127414796f; q = q * t;
    const f32x2 s = (v * v) * (-0.72134752044f);
    f32x2 e; e.x = __builtin_amdgcn_exp2f(s.x); e.y = __builtin_amdgcn_exp2f(s.y);
    const f32x2 m = v * (q * e), r = v - m;
    f32x2 o; o.x = v.x < 0.f ? m.x : r.x; o.y = v.y < 0.f ? m.y : r.y; return o;
}

__host__ __device__ __forceinline__ int lds_byte(int r, int c) { const int st = (r >> 4) * 2 + (c >> 5), rr = r & 15, cc = c & 31, ob = rr * 64 + cc * 2; return st * 1024 + (ob ^ (((ob >> 9) & 1) << 5)); }
__host__ __device__ __forceinline__ void stage_rc(int b, int& R, int& C) { const int st = b / 1024, sb = b % 1024, swz = sb ^ (((sb >> 9) & 1) << 5); R = (st >> 1) * 16 + swz / 64; C = (st & 1) * 32 + (swz % 64) / 2; }
__host__ __device__ __forceinline__ int perm32(int rho) { const int n = rho >> 4, i = rho & 15; return 8 * (i >> 2) + 4 * n + (i & 3); }

struct Unit { int pm, pn; };
struct StaticOrder {
    int nM, nN, nwg, G, c;
    __device__ void init(int M, int N, int G_, int c_) { nM = M / BM; nN = N / BM; nwg = nM * nN; G = G_; c = c_; }
    __device__ bool next(int i, Unit& u) const {
        const long L = (long)i * G + c; if (L >= nwg) return false;
        int wgid = (int)L; { const int q = nwg / NXCD, r = nwg % NXCD, xcd = wgid % NXCD, off = wgid / NXCD; wgid = (xcd < r ? xcd * (q + 1) : r * (q + 1) + (xcd - r) * q) + off; }
        const int nig = WGM * nN, gid = wgid / nig, fm = gid * WGM, gsz = (nM - fm) < WGM ? (nM - fm) : WGM;
        u.pm = fm + ((wgid % nig) % gsz); u.pn = (wgid % nig) / gsz; return true;
    }
};
struct Epi { int mode; bf16_t* ob; int ldob; float* of; const float* res; float* st_out; const float* st_in; unsigned* cnt; const float* gain; const bf16_t* resb; };

template <int MODE>
__device__ __forceinline__ void epi_prep(const Epi& E, const Unit& u, LAS float* rs) {
    if (MODE == 0 || MODE == 2 || MODE == 3) {
        const int tid = threadIdx.x, row = tid >> 1, half = tid & 1;
        const f32x4* p = (const f32x4*)(E.st_in + ((size_t)(u.pm * BM + row) * 32 + half * 16));
        const f32x4 a = p[0], b = p[1], c = p[2], d = p[3];
        float s = ((a.x + a.y) + (a.z + a.w)) + ((b.x + b.y) + (b.z + b.w)) + ((c.x + c.y) + (c.z + c.w)) + ((d.x + d.y) + (d.z + d.w));
        s += __shfl_xor(s, 1);
        if (!half) rs[row] = __builtin_amdgcn_rsqf(s * (1.0f / DM) + EPS);
    }
}

template <int MODE>
__device__ __forceinline__ void epi_run(const Epi& E, const f32x4 (&acc)[2][2][4][2], const Unit& u, int wr, int wc, int fr, int fq, const LAS float* rs) {
    const int rl0 = wr * 64 + fr, col0 = u.pn * BM + wc * 32 + 8 * fq;
    constexpr int mode = MODE;
    if (mode == 5) {
        const int lane = fr + 16 * fq;
        unsigned* cw = E.cnt + u.pm * 64;
#pragma unroll
        for (int ai = 0; ai < 2; ++ai)
#pragma unroll
            for (int m = 0; m < 4; ++m) {
                const size_t row = (size_t)(u.pm * BM + rl0 + ai * HALF + m * 16);
                float ss = 0.f;
#pragma unroll
                for (int bj = 0; bj < 2; ++bj) { const f32x4 v0 = acc[ai][bj][m][0], v1 = acc[ai][bj][m][1];
                    ss += (v0.x * v0.x + v0.y * v0.y) + (v0.z * v0.z + v0.w * v0.w) + (v1.x * v1.x + v1.y * v1.y) + (v1.z * v1.z + v1.w * v1.w); }
                ss += __shfl_xor(ss, 16); ss += __shfl_xor(ss, 32);
                if (fq == 0) __hip_atomic_store((unsigned*)(E.st_out + row * 32 + u.pn * 4 + wc), __float_as_uint(ss), __ATOMIC_RELAXED, __HIP_MEMORY_SCOPE_AGENT);
            }
        asm volatile("s_waitcnt vmcnt(0)" ::: "memory");
        if (lane == 0) (void)__hip_atomic_fetch_add(cw, 1u, __ATOMIC_RELAXED, __HIP_MEMORY_SCOPE_AGENT);
        { unsigned sp = 0;
          while ((unsigned)__builtin_amdgcn_readfirstlane(__hip_atomic_load(cw, __ATOMIC_RELAXED, __HIP_MEMORY_SCOPE_AGENT)) < 64u) { __builtin_amdgcn_s_sleep(2); if (++sp > (1u << 22)) break; } }
        __builtin_amdgcn_fence(__ATOMIC_ACQUIRE, "agent");
        asm volatile("s_waitcnt vmcnt(0)" ::: "memory");
        f32x4 gv[2][2];
#pragma unroll
        for (int bj = 0; bj < 2; ++bj) { gv[bj][0] = *(const f32x4*)(E.gain + col0 + bj * HALF); gv[bj][1] = *(const f32x4*)(E.gain + col0 + bj * HALF + 4); }
#pragma unroll
        for (int ai = 0; ai < 2; ++ai)
#pragma unroll
            for (int m = 0; m < 4; ++m) {
                const size_t row = (size_t)(u.pm * BM + rl0 + ai * HALF + m * 16);
                const f32x4* pp = (const f32x4*)(E.st_out + row * 32 + 8 * fq);
                const f32x4 pa = pp[0], pb = pp[1];
                float s = ((pa.x + pa.y) + (pa.z + pa.w)) + ((pb.x + pb.y) + (pb.z + pb.w));
                s += __shfl_xor(s, 16); s += __shfl_xor(s, 32);
                const float r = __builtin_amdgcn_rsqf(s * (1.0f / DM) + EPS);
                float* op = E.of + row * DM + col0;
#pragma unroll
                for (int bj = 0; bj < 2; ++bj) { *(f32x4*)(op + bj * HALF) = acc[ai][bj][m][0] * r * gv[bj][0]; *(f32x4*)(op + bj * HALF + 4) = acc[ai][bj][m][1] * r * gv[bj][1]; }
                asm volatile("" ::: "memory");
            }
    } else if (mode == 1 || mode == 6) {
#pragma unroll
        for (int ai = 0; ai < 2; ++ai)
#pragma unroll
            for (int m = 0; m < 4; ++m) {
                const size_t row = (size_t)(u.pm * BM + rl0 + ai * HALF + m * 16);
                float ss = 0.f;
#pragma unroll
                for (int bj = 0; bj < 2; ++bj) {
                    const f32x4 v0 = acc[ai][bj][m][0], v1 = acc[ai][bj][m][1];
                    ss += (v0.x * v0.x + v0.y * v0.y) + (v0.z * v0.z + v0.w * v0.w) + (v1.x * v1.x + v1.y * v1.y) + (v1.z * v1.z + v1.w * v1.w);
                    u32x4 w; w.x = cvt_pk_bf16(v0.x, v0.y); w.y = cvt_pk_bf16(v0.z, v0.w); w.z = cvt_pk_bf16(v1.x, v1.y); w.w = cvt_pk_bf16(v1.z, v1.w);
                    *(u32x4*)(E.ob + row * E.ldob + col0 + bj * HALF) = w;
                }
                ss += __shfl_xor(ss, 16); ss += __shfl_xor(ss, 32);
                if (fq == 0) E.st_out[row * 32 + u.pn * 4 + wc] = ss;
                asm volatile("" ::: "memory");
            }
    } else {
        const bool vstat = (mode == 0) && (u.pn >= 8);
#pragma unroll
        for (int ai = 0; ai < 2; ++ai)
#pragma unroll
            for (int m = 0; m < 4; ++m) {
                const int rl = rl0 + ai * HALF + m * 16;
                const size_t row = (size_t)(u.pm * BM + rl);
                const float r = (mode == 4) ? 1.0f : rs[rl];
                float s1 = 0.f, s2 = 0.f;
#pragma unroll
                for (int bj = 0; bj < 2; ++bj) {
                    f32x4 v0 = acc[ai][bj][m][0] * r, v1 = acc[ai][bj][m][1] * r;
                    if (mode == 0) {
                        const f32x2 a = gelu_pk((f32x2){v0.x, v0.y}), b = gelu_pk((f32x2){v0.z, v0.w}), c = gelu_pk((f32x2){v1.x, v1.y}), d = gelu_pk((f32x2){v1.z, v1.w});
                        v0 = (f32x4){a.x, a.y, b.x, b.y}; v1 = (f32x4){c.x, c.y, d.x, d.y};
                        s1 += ((v0.x + v0.y) + (v0.z + v0.w)) + ((v1.x + v1.y) + (v1.z + v1.w));
                        s2 += (v0.x * v0.x + v0.y * v0.y) + (v0.z * v0.z + v0.w * v0.w) + (v1.x * v1.x + v1.y * v1.y) + (v1.z * v1.z + v1.w * v1.w);
                    } else if (mode == 2) {
                        v0 = __builtin_elementwise_max(v0, (f32x4){0.f, 0.f, 0.f, 0.f}); v1 = __builtin_elementwise_max(v1, (f32x4){0.f, 0.f, 0.f, 0.f});
                        v0 = v0 * v0; v1 = v1 * v1;
                    }
                    u32x4 w; w.x = cvt_pk_bf16(v0.x, v0.y); w.y = cvt_pk_bf16(v0.z, v0.w); w.z = cvt_pk_bf16(v1.x, v1.y); w.w = cvt_pk_bf16(v1.z, v1.w);
                    *(u32x4*)(E.ob + row * E.ldob + col0 + bj * HALF) = w;
                }
                if (vstat) {
                    s1 += __shfl_xor(s1, 16); s1 += __shfl_xor(s1, 32); s2 += __shfl_xor(s2, 16); s2 += __shfl_xor(s2, 32);
                    if (fq == 0) *(f32x2*)(E.st_out + (row * 32 + (u.pn - 8) * 4 + wc) * 2) = (f32x2){s1, s2};
                }
                asm volatile("" ::: "memory");
            }
    }
}

template <int MODE, int N, int K, int LDA, bool GROUPED, int M = MTOK>
__device__ __forceinline__ void gemm_phase(LAS unsigned char* lds, const bf16_t* gA, const bf16_t* gBt, const Epi& E, int G, int c) {
    const int tid = threadIdx.x, wid = __builtin_amdgcn_readfirstlane(tid >> 6), lane = tid & 63, wr = wid >> 2, wc = wid & 3, fr = lane & 15, fq = lane >> 4;
    constexpr int nt = K / BK, lda = LDA;
    constexpr bool RELAX = false;
    StaticOrder S; S.init(M, N, G, c);
    LAS float* rsl = (LAS float*)(lds + RS_OFF);
    unsigned voffA[2], voffB[2];
#pragma unroll
    for (int i = 0; i < 2; ++i) { int R, C; stage_rc(tid * 16 + i * 8192, R, C); const int Rb = (R & ~31) + perm32(R & 31);
        voffA[i] = (unsigned)(R * lda + C) * 2u; voffB[i] = (unsigned)(Rb * K + C) * 2u; }
    const size_t kstep = (size_t)(BK * 2);
    const size_t hstepA = (size_t)HALF * lda * 2, hstepB = (size_t)HALF * K * 2;
    const size_t tstepA = 2 * hstepA, tstepB = 2 * hstepB;
    const unsigned ldsw = (unsigned)wid * 1024u;
    const int aoff = lds_byte(wr * 64 + fr, fq * 8), boff = lds_byte(wc * 32 + fr, fq * 8);
#define PG8_SA(b, h) (((b) * 2 + (h)) * HTB)
#define PG8_SB(b, h) ((4 + (b) * 2 + (h)) * HTB)
#define PG8_STAGE(bufoff, gbase, voff) do { const char* _g = (const char*)(gbase); asm volatile("" : "+s"(_g)); _Pragma("unroll") for (int _i = 0; _i < 2; ++_i) { unsigned _v = (voff)[_i]; asm volatile("" : "+v"(_v)); \
        __builtin_amdgcn_global_load_lds((const unsigned*)(_g + _v), (LAS unsigned*)(lds + (bufoff) + ldsw + _i * 8192), 16, 0, 0); } } while (0)
#define PG8_LDA(dst, b, h) do { _Pragma("unroll") for (int m = 0; m < 4; ++m) _Pragma("unroll") for (int k = 0; k < 2; ++k) dst[m][k] = *(const LAS bf16x8*)(lds + PG8_SA(b, h) + aoff + m * 2048 + k * 1024); } while (0)
#define PG8_LDB(dst, b, h) do { _Pragma("unroll") for (int n = 0; n < 2; ++n) _Pragma("unroll") for (int k = 0; k < 2; ++k) dst[n][k] = *(const LAS bf16x8*)(lds + PG8_SB(b, h) + boff + n * 2048 + k * 1024); } while (0)
#define PG8_MMA(ai, bj, At, Bt) do { __builtin_amdgcn_s_setprio(1); _Pragma("unroll") for (int m = 0; m < 4; ++m) _Pragma("unroll") for (int n = 0; n < 2; ++n) _Pragma("unroll") for (int k = 0; k < 2; ++k) \
        acc[ai][bj][m][n] = __builtin_amdgcn_mfma_f32_16x16x32_bf16(Bt[n][k], At[m][k], acc[ai][bj][m][n], 0, 0, 0); __builtin_amdgcn_s_setprio(0); } while (0)
#define PG8_WAIT_V(n) asm volatile("s_waitcnt vmcnt(" #n ")" ::: "memory")
#define PG8_WAIT_V8_OR24(flag) asm volatile("s_cmp_lg_u32 %0, 0\n\ts_cbranch_scc1 1f\n\ts_waitcnt vmcnt(8)\n1:\n\ts_waitcnt vmcnt(24)" :: "s"(flag) : "memory", "scc")
#define PG8_WAIT_L(n) asm volatile("s_waitcnt lgkmcnt(" #n ")" ::: "memory")
#define PG8_BAR __builtin_amdgcn_s_barrier()
#define PG8_SCHED __builtin_amdgcn_sched_barrier(0)
#define UNIT_A(u) ((const char*)gA + (size_t)(u).pm * tstepA + (GROUPED ? (size_t)(((u).pn >> 1) * 512) * 2 : (size_t)0))
    Unit cur, nxt; int ui = 0;
    if (!S.next(0, cur)) return;
    f32x4 acc[2][2][4][2];
#define ACC_INIT(u) do { \
    _Pragma("unroll") for (int a_ = 0; a_ < 2; ++a_) _Pragma("unroll") for (int m_ = 0; m_ < 4; ++m_) { \
        const size_t ro_ = (size_t)((u).pm * BM + wr * 64 + fr + a_ * HALF + m_ * 16) * DM + (u).pn * BM + wc * 32 + 8 * fq; \
        _Pragma("unroll") for (int b_ = 0; b_ < 2; ++b_) { \
            if (MODE == 1) { acc[a_][b_][m_][0] = *(const f32x4*)(E.res + ro_ + b_ * HALF); acc[a_][b_][m_][1] = *(const f32x4*)(E.res + ro_ + b_ * HALF + 4); } \
            else if (MODE == 6 || MODE == 5) { const u32x4 w_ = *(const u32x4*)(E.resb + ro_ + b_ * HALF); \
                acc[a_][b_][m_][0] = (f32x4){bf_lo(w_.x), bf_hi(w_.x), bf_lo(w_.y), bf_hi(w_.y)}; acc[a_][b_][m_][1] = (f32x4){bf_lo(w_.z), bf_hi(w_.z), bf_lo(w_.w), bf_hi(w_.w)}; } \
            else { acc[a_][b_][m_][0] = (f32x4){0.f, 0.f, 0.f, 0.f}; acc[a_][b_][m_][1] = (f32x4){0.f, 0.f, 0.f, 0.f}; } } } } while (0)
    ACC_INIT(cur);
    bf16x8 At[4][2], B0[2][2], B1[2][2];
    const char* cA = UNIT_A(cur); const char* cB = (const char*)gBt + (size_t)cur.pn * tstepB;
    int slot = 0;
    PG8_STAGE(PG8_SB(0, 0), cB, voffB); PG8_STAGE(PG8_SB(0, 1), cB + hstepB, voffB); PG8_STAGE(PG8_SA(0, 0), cA, voffA); PG8_STAGE(PG8_SA(0, 1), cA + hstepA, voffA);
    PG8_STAGE(PG8_SB(1, 0), cB + kstep, voffB); PG8_STAGE(PG8_SA(1, 0), cA + kstep, voffA); PG8_STAGE(PG8_SB(1, 1), cB + hstepB + kstep, voffB);
    epi_prep<MODE>(E, cur, rsl);
    if (wr == 1) PG8_BAR;
    PG8_WAIT_V(8); PG8_BAR;
    PG8_WAIT_V(6); PG8_BAR;
    for (;;) {
        const bool has_next = S.next(ui + 1, nxt);
        const char* nA = has_next ? UNIT_A(nxt) : cA; const char* nB = has_next ? (const char*)gBt + (size_t)nxt.pn * tstepB : cB;
        for (int t = 0; t < nt; t += 2) {
            const bool last = (t == nt - 2);
            const char* a1 = cA + (size_t)(t + 1) * kstep;
            const char* a2 = last ? nA : cA + (size_t)(t + 2) * kstep; const char* b2 = last ? nB : cB + (size_t)(t + 2) * kstep;
            const char* a3 = a2 + kstep; const char* b3 = b2 + kstep;
            const int rflag = __builtin_amdgcn_readfirstlane((RELAX && t == 0 && ui > 0) ? 1 : 0);
            PG8_LDB(B0, 0, 0); PG8_LDB(B1, 0, 1); PG8_SCHED; PG8_LDA(At, 0, 0); PG8_STAGE(PG8_SA(1, 1), a1 + hstepA, voffA);
            if constexpr (RELAX) PG8_WAIT_V8_OR24(rflag); else PG8_WAIT_V(8);
            PG8_WAIT_L(0); PG8_BAR; PG8_MMA(0, 0, At, B0); PG8_MMA(0, 1, At, B1); PG8_BAR; PG8_SCHED;
            PG8_LDA(At, 0, 1); PG8_STAGE(PG8_SB(0, 0), b2, voffB); PG8_STAGE(PG8_SB(0, 1), b2 + hstepB, voffB); PG8_STAGE(PG8_SA(0, 0), a2, voffA);
            if constexpr (RELAX) PG8_WAIT_V8_OR24(rflag); else PG8_WAIT_V(8);
            PG8_WAIT_L(0); PG8_BAR; PG8_MMA(1, 0, At, B0); PG8_MMA(1, 1, At, B1); PG8_BAR; PG8_SCHED;
            PG8_LDB(B0, 1, 0); PG8_LDB(B1, 1, 1); PG8_SCHED; PG8_LDA(At, 1, 0); PG8_STAGE(PG8_SA(0, 1), a2 + hstepA, voffA);
            PG8_WAIT_V(8); PG8_WAIT_L(0); PG8_BAR; PG8_MMA(0, 0, At, B0); PG8_MMA(0, 1, At, B1); PG8_BAR; PG8_SCHED;
            PG8_LDA(At, 1, 1); PG8_STAGE(PG8_SB(1, 0), b3, voffB); PG8_STAGE(PG8_SB(1, 1), b3 + hstepB, voffB); PG8_STAGE(PG8_SA(1, 0), a3, voffA);
            PG8_WAIT_V(8); PG8_WAIT_L(0); PG8_BAR; PG8_MMA(1, 0, At, B0); PG8_MMA(1, 1, At, B1); PG8_BAR; PG8_SCHED;
        }
        if (wr == 0) PG8_BAR;
        epi_run<MODE>(E, acc, cur, wr, wc, fr, fq, rsl + slot * 256);
        if (!has_next) break;
        const bool new_panel = (nxt.pm != cur.pm);
        cur = nxt; cA = nA; cB = nB; ++ui;
        ACC_INIT(cur);
        if (new_panel) { slot ^= 1; epi_prep<MODE>(E, cur, rsl + slot * 256); }
        if (wr == 1) PG8_BAR;
    }
    PG8_WAIT_V(0);
    PG8_BAR;
#undef PG8_SA
#undef PG8_SB
#undef PG8_STAGE
#undef PG8_LDA
#undef PG8_LDB
#undef PG8_MMA
#undef PG8_WAIT_V
#undef PG8_WAIT_L
#undef PG8_WAIT_V8_OR24
#undef PG8_BAR
#undef PG8_SCHED
#undef UNIT_A
#undef ACC_INIT
}

__device__ __forceinline__ void p0_transpose_item(const float* W, const float* sc, int K, int N, bf16_t* WT, LAS float* scr, int item, int lane) {
    const int nblk = N / 64, kb = item / nblk, nb = item % nblk, k0 = 64 * kb, n0 = 64 * nb;
    const int r = lane >> 4, c16 = lane & 15;
    f32x4 v[16];
    const float* src = W + (size_t)(k0 + r) * N + n0 + 4 * c16;
#pragma unroll
    for (int i = 0; i < 16; ++i) v[i] = __builtin_nontemporal_load((const f32x4*)(src + (size_t)(4 * i) * N));
    const int c = lane & 7;
    f32x4 s0 = (f32x4){1.f, 1.f, 1.f, 1.f}, s1 = s0;
    if (sc) { s0 = *(const f32x4*)(sc + k0 + 8 * c); s1 = *(const f32x4*)(sc + k0 + 8 * c + 4); }
#pragma unroll
    for (int i = 0; i < 16; ++i) { LAS float* d = scr + (4 * i + r) * 65 + 4 * c16; d[0] = v[i].x; d[1] = v[i].y; d[2] = v[i].z; d[3] = v[i].w; }
    LDS_WAIT(); asm volatile("" ::: "memory");
#pragma unroll
    for (int j = 0; j < 8; ++j) { const int n = (lane >> 3) + 8 * j; const LAS float* s = scr + (8 * c) * 65 + n;
        u32x4 o; o.x = cvt_pk_bf16(s[0 * 65] * s0.x, s[1 * 65] * s0.y); o.y = cvt_pk_bf16(s[2 * 65] * s0.z, s[3 * 65] * s0.w);
        o.z = cvt_pk_bf16(s[4 * 65] * s1.x, s[5 * 65] * s1.y); o.w = cvt_pk_bf16(s[6 * 65] * s1.z, s[7 * 65] * s1.w);
        *(u32x4*)(WT + (size_t)(n0 + n) * K + k0 + 8 * c) = o; }
    LDS_WAIT(); asm volatile("" ::: "memory");
}

__device__ __forceinline__ void p0_phase(LAS unsigned char* lds, const Args& a, const bool skip_l1mlp) {
    const int tid = threadIdx.x, wave = __builtin_amdgcn_readfirstlane(tid >> 6), lane = tid & 63;
    LAS float* scr = (LAS float*)(lds + wave * 16640);
    const int gw = blockIdx.x * 8 + wave, NGW = gridDim.x * 8;
    unsigned char* ws = a.ws;
    constexpr int I_AIN = 32 * 64, I_SQ = 32 * 32, I_W1 = 32 * 128, I_W2 = 128 * 32, I_GRP = 8 * 8;
    constexpr int NITEMS = I_AIN + 3 * I_SQ + 2 * I_W1 + 2 * I_W2;
    for (int it = gw; it < NITEMS; it += NGW) {
        int r = it;
        if (r < I_W1) { if (!skip_l1mlp) p0_transpose_item(a.mlp_w1, a.norm_mlp, DM, FF, (bf16_t*)(ws + WS_WT_W1_0), scr, r, lane); continue; } r -= I_W1;
        if (r < I_W1) { if (!skip_l1mlp) p0_transpose_item(a.mlp_w1 + (size_t)DM * FF, a.norm_mlp + DM, DM, FF, (bf16_t*)(ws + WS_WT_W1_1), scr, r, lane); continue; } r -= I_W1;
        if (r < I_W2) { if (!skip_l1mlp) p0_transpose_item(a.mlp_w2, nullptr, FF, DM, (bf16_t*)(ws + WS_WT_W2_0), scr, r, lane); continue; } r -= I_W2;
        if (r < I_W2) { if (!skip_l1mlp) p0_transpose_item(a.mlp_w2 + (size_t)DM * FF, nullptr, FF, DM, (bf16_t*)(ws + WS_WT_W2_1), scr, r, lane); continue; } r -= I_W2;
        if (r < I_AIN) { p0_transpose_item(a.a_w_in, a.norm_mix, DM, 4096, (bf16_t*)(ws + WS_WT_AIN), scr, r, lane); continue; } r -= I_AIN;
        if (r < I_SQ) { p0_transpose_item(a.a_w_out, nullptr, DM, DM, (bf16_t*)(ws + WS_WT_AOUT), scr, r, lane); continue; } r -= I_SQ;
        if (r < I_SQ) { p0_transpose_item(a.b_w_in, a.norm_mix + DM, DM, DM, (bf16_t*)(ws + WS_WT_BIN), scr, r, lane); continue; } r -= I_SQ;
        p0_transpose_item(a.b_w_out, a.b_scale, DM, DM, (bf16_t*)(ws + WS_WT_BOUT), scr, r, lane);
    }
    for (int it = gw; it < 2048; it += NGW) {
        const f32x4* sp = (const f32x4*)(a.b_w_grp + (size_t)it * 512) + 2 * lane; const f32x4 p = sp[0], q = sp[1];
        u32x4 o; o.x = cvt_pk_bf16(p.x, p.y); o.y = cvt_pk_bf16(p.z, p.w); o.z = cvt_pk_bf16(q.x, q.y); o.w = cvt_pk_bf16(q.z, q.w);
        *((u32x4*)((bf16_t*)(ws + WS_WT_GRP) + (size_t)it * 512) + lane) = o;
    }
    bf16_t* XB = (bf16_t*)(ws + WS_HB); float* XST = (float*)(ws + WS_XST);
    for (int m = gw; m < MTOK; m += NGW) {
        const f32x4* xr = (const f32x4*)(a.x + (size_t)m * DM) + lane;
        f32x4 v[8]; float s = 0.f;
#pragma unroll
        for (int j = 0; j < 8; ++j) { v[j] = __builtin_nontemporal_load(xr + 64 * j); s += (v[j].x * v[j].x + v[j].y * v[j].y) + (v[j].z * v[j].z + v[j].w * v[j].w); }
        s = wave_sum(s);
        u32x2* o8 = (u32x2*)(XB + (size_t)m * DM) + lane;
#pragma unroll
        for (int j = 0; j < 8; ++j) { u32x2 w; w.x = cvt_pk_bf16(v[j].x, v[j].y); w.y = cvt_pk_bf16(v[j].z, v[j].w); o8[64 * j] = w; }
        if (lane < 32) XST[(size_t)m * 32 + lane] = (lane == 0) ? s : 0.f;
    }
}

__device__ __forceinline__ void spatial_phase(LAS unsigned char* lds, const Args& a, int first, int stride) {
    const int tid = threadIdx.x, wid = __builtin_amdgcn_readfirstlane(tid >> 6), lane = tid & 63, fr = lane & 15, fq = lane >> 4;
    LAS unsigned* VT = (LAS unsigned*)lds;
    LAS unsigned char* WL = lds + 69632;
    LAS float* MR = (LAS float*)(lds + 104448);
    const bf16_t* Z = (const bf16_t*)(a.ws + WS_ACT);
    bf16_t* GATED = (bf16_t*)(a.ws + WS_ACT + (size_t)MTOK * 4096 * 2);
    const float* VST = (const float*)(a.ws + WS_VST);
    for (int it = first; it < 512; it += stride) {
        const int g = it & 7, tok0 = (it >> 3) * 128;
        if (tid < 256) {
            const int row = tid >> 1, half = tid & 1;
            const f32x4* p = (const f32x4*)(VST + ((size_t)(tok0 + row) * 32 + half * 16) * 2);
            float s1 = 0.f, s2 = 0.f;
#pragma unroll
            for (int j = 0; j < 8; ++j) { const f32x4 q = p[j]; s1 += q.x + q.z; s2 += q.y + q.w; }
            s1 += __shfl_xor(s1, 1); s2 += __shfl_xor(s2, 1);
            const float mean = s1 * (1.0f / 2048.0f), var = s2 * (1.0f / 2048.0f) - mean * mean;
            if (!half) { MR[row] = mean; MR[128 + row] = __builtin_amdgcn_rsqf(var + EPS); }
        }
        const float* Wg = a.a_w_s + (size_t)g * 16384;
#pragma unroll
        for (int i = 0; i < 8; ++i) {
            const int idx = (i * 512 + tid) * 4, t = idx >> 7, s = idx & 127;
            f32x4 w = *(const f32x4*)(Wg + idx);
            w.x = (s <= t) ? w.x : 0.f; w.y = (s + 1 <= t) ? w.y : 0.f; w.z = (s + 2 <= t) ? w.z : 0.f; w.w = (s + 3 <= t) ? w.w : 0.f;
            u32x2 o; o.x = cvt_pk_bf16(w.x, w.y); o.y = cvt_pk_bf16(w.z, w.w);
            *(LAS u32x2*)(WL + (t * 136 + s) * 2) = o;
        }
        __syncthreads();
        {
            const float m0 = MR[2 * lane], m1 = MR[2 * lane + 1], r0 = MR[128 + 2 * lane], r1 = MR[128 + 2 * lane + 1];
#pragma unroll
            for (int pass = 0; pass < 4; ++pass) {
                const int d0 = (wid + 8 * pass) * 8;
                const bf16_t* zp = Z + (size_t)(tok0 + 2 * lane) * 4096 + 2048 + g * 256 + d0;
                const u32x4 va = *(const u32x4*)zp, vb = *(const u32x4*)(zp + 4096);
                const f32x4 g0 = *(const f32x4*)(a.a_ln_g + g * 256 + d0), g1 = *(const f32x4*)(a.a_ln_g + g * 256 + d0 + 4);
                const f32x4 b0 = *(const f32x4*)(a.a_ln_b + g * 256 + d0), b1 = *(const f32x4*)(a.a_ln_b + g * 256 + d0 + 4);
                const float gg[8] = {g0.x, g0.y, g0.z, g0.w, g1.x, g1.y, g1.z, g1.w}, bb[8] = {b0.x, b0.y, b0.z, b0.w, b1.x, b1.y, b1.z, b1.w};
#pragma unroll
                for (int i = 0; i < 8; ++i) {
                    const unsigned wa = va[i >> 1], wb = vb[i >> 1];
                    const float x0 = (i & 1) ? bf_hi(wa) : bf_lo(wa), x1 = (i & 1) ? bf_hi(wb) : bf_lo(wb);
                    const float y0 = (x0 - m0) * r0 * gg[i] + bb[i], y1 = (x1 - m1) * r1 * gg[i] + bb[i];
                    VT[(d0 + i) * 68 + lane] = cvt_pk_bf16(y0, y1);
                }
            }
        }
        __syncthreads();
        f32x4 acc[8][2];
#pragma unroll
        for (int mt = 0; mt < 8; ++mt) { acc[mt][0] = (f32x4){0.f, 0.f, 0.f, 0.f}; acc[mt][1] = (f32x4){0.f, 0.f, 0.f, 0.f}; }
        bf16x8 X[2][4];
#pragma unroll
        for (int nd = 0; nd < 2; ++nd)
#pragma unroll
            for (int kk = 0; kk < 4; ++kk) X[nd][kk] = *(const LAS bf16x8*)(lds + ((32 * wid + 16 * nd + fr) * 136 + 32 * kk + 8 * fq) * 2);
#pragma unroll
        for (int mt = 0; mt < 8; ++mt)
#pragma unroll
            for (int kk = 0; kk < 4; ++kk)
                if (32 * kk <= 16 * mt + 15) {
                    const bf16x8 Y = *(const LAS bf16x8*)(WL + ((16 * mt + fr) * 136 + 32 * kk + 8 * fq) * 2);
                    acc[mt][0] = __builtin_amdgcn_mfma_f32_16x16x32_bf16(X[0][kk], Y, acc[mt][0], 0, 0, 0);
                    acc[mt][1] = __builtin_amdgcn_mfma_f32_16x16x32_bf16(X[1][kk], Y, acc[mt][1], 0, 0, 0);
                }
#pragma unroll
        for (int mt = 0; mt < 8; ++mt) {
            const int t = 16 * mt + fr; const float bias = a.a_b_s[g * 128 + t];
#pragma unroll
            for (int nd = 0; nd < 2; ++nd) {
                const int d = 32 * wid + 16 * nd + 4 * fq;
                const u32x2 uu = *(const u32x2*)(Z + (size_t)(tok0 + t) * 4096 + g * 256 + d);
                const f32x4 sv = acc[mt][nd] + bias;
                u32x2 o; o.x = cvt_pk_bf16(sv.x * bf_lo(uu.x), sv.y * bf_hi(uu.x)); o.y = cvt_pk_bf16(sv.z * bf_lo(uu.y), sv.w * bf_hi(uu.y));
                *(u32x2*)(GATED + (size_t)(tok0 + t) * DM + g * 256 + d) = o;
            }
        }
        __syncthreads();
    }
}

__device__ __forceinline__ void unpack8(const u32x4 w, float (&f)[8]) {
    f[0] = bf_lo(w.x); f[1] = bf_hi(w.x); f[2] = bf_lo(w.y); f[3] = bf_hi(w.y); f[4] = bf_lo(w.z); f[5] = bf_hi(w.z); f[6] = bf_lo(w.w); f[7] = bf_hi(w.w);
}
template <int W>
__device__ __forceinline__ void pool_run(const bf16_t* vp, bf16_t* pp, int p0) {
    u32x4 raw[W + 15];
#pragma unroll
    for (int j = 0; j < W + 15; ++j) { const int row = j - (W - 1);
        raw[j] = (row >= 0 || p0 > 0) ? *(const u32x4*)(vp + (ptrdiff_t)row * DM) : (u32x4){0u, 0u, 0u, 0u}; }
    float sum[8];
#pragma unroll
    for (int k = 0; k < 8; ++k) sum[k] = 0.f;
#pragma unroll
    for (int j = 0; j < W - 1; ++j) { float f[8]; unpack8(raw[j], f);
#pragma unroll
        for (int k = 0; k < 8; ++k) sum[k] += f[k]; }
#pragma unroll
    for (int i = 0; i < 16; ++i) {
        const int p = p0 + i; float c[8], f[8]; unpack8(raw[W - 1 + i], c); unpack8(raw[i], f);
        const int cnt = (p + 1 < W) ? (p + 1) : W; const float inv = 1.0f / (float)cnt;
        float o[8];
#pragma unroll
        for (int k = 0; k < 8; ++k) { sum[k] += c[k]; o[k] = sum[k] * inv - c[k]; sum[k] -= f[k]; }
        u32x4 ov; ov.x = cvt_pk_bf16(o[0], o[1]); ov.y = cvt_pk_bf16(o[2], o[3]); ov.z = cvt_pk_bf16(o[4], o[5]); ov.w = cvt_pk_bf16(o[6], o[7]);
        *(u32x4*)(pp + (size_t)i * DM) = ov;
    }
}
__device__ __forceinline__ void pool_phase(const Args& a, int first_blk, int nblk) {
    const bf16_t* V = (const bf16_t*)(a.ws + WS_ACT);
    bf16_t* P = (bf16_t*)(a.ws + WS_ACT + (size_t)MTOK * DM * 2);
    for (int gid = first_blk * 512 + (int)threadIdx.x; gid < (MTOK / 16) * 256; gid += nblk * 512) {
        const int cc = gid & 255, t0 = (gid >> 8) * 16, p0 = t0 & (SEQ - 1);
        const int grp = __builtin_amdgcn_readfirstlane(cc >> 6);
        const bf16_t* vp = V + (size_t)t0 * DM + cc * 8; bf16_t* pp = P + (size_t)t0 * DM + cc * 8;
        if (grp == 0) pool_run<2>(vp, pp, p0); else if (grp == 1) pool_run<4>(vp, pp, p0); else if (grp == 2) pool_run<8>(vp, pp, p0); else pool_run<16>(vp, pp, p0);
    }
}

__device__ __forceinline__ void final_phase(const Args& a) {
    const int tid = threadIdx.x, wave = tid >> 6, lane = tid & 63;
    const float* HST = (const float*)(a.ws + WS_HST4);
    for (int m = blockIdx.x * 8 + wave; m < MTOK; m += gridDim.x * 8) {
        float s = (lane < 32) ? HST[(size_t)m * 32 + lane] : 0.f;
        s = wave_sum(s);
        const float r = __builtin_amdgcn_rsqf(s * (1.0f / DM) + EPS);
        f32x4* op = (f32x4*)(a.out + (size_t)m * DM) + lane; const f32x4* gp = (const f32x4*)a.final_norm + lane;
#pragma unroll
        for (int j = 0; j < 8; ++j) { const f32x4 v = op[64 * j], gg = gp[64 * j]; op[64 * j] = v * r * gg; }
    }
}

#define XB_TMO      128
#define XB_XCNT(j)  (256  + 64 * (j))
#define XB_XSUB(j)  (1280 + 64 * (j))
#define XB_XGEN(j)  (2304 + 64 * (j))
#define XB_TOP      3328
#define XB_TOPGEN   3392
#define XCD_BAR_WORDS 3456
#define XB_SPIN_CAP (1u << 18)
__device__ __forceinline__ unsigned xb_ld(unsigned* p)              { return __hip_atomic_load(p, __ATOMIC_RELAXED, __HIP_MEMORY_SCOPE_AGENT); }
__device__ __forceinline__ unsigned xb_add(unsigned* p, unsigned v) { return __hip_atomic_fetch_add(p, v, __ATOMIC_RELAXED, __HIP_MEMORY_SCOPE_AGENT); }
__device__ __forceinline__ unsigned xb_xcc_id() { return (unsigned)__builtin_amdgcn_s_getreg((3 << 11) | 20) & 0xFu; }
#define XB_SPIN(cond, bar) do { unsigned _sp = 0; while (cond) { __builtin_amdgcn_s_sleep(1); \
    if ((++_sp & 255u) == 0u) { if (xb_ld(&(bar)[XB_TMO])) break; if (_sp > XB_SPIN_CAP) { atomicAdd(&(bar)[XB_TMO], 1u); break; } } } } while (0)
struct XcdBarrier { unsigned* bar; unsigned x; volatile LAS unsigned* st; };
__device__ __forceinline__ XcdBarrier xcd_barrier_post(unsigned* bar, volatile LAS unsigned* st) {
    XcdBarrier b; b.bar = bar; b.x = xb_xcc_id(); b.st = st;
    if (threadIdx.x == 0) (void)xb_add(&bar[XB_XCNT(b.x)], 1u);
    return b;
}
__device__ __forceinline__ void xcd_barrier_complete(unsigned* bar, unsigned x, unsigned& nloc, unsigned& nx) {
    const unsigned G = gridDim.x * gridDim.y * gridDim.z;
    unsigned sum, cnt, mine, sp = 0u;
    for (;;) {
        sum = 0u; cnt = 0u; mine = 0u;
#pragma unroll
        for (unsigned j = 0; j < 16; ++j) { const unsigned c = xb_ld(&bar[XB_XCNT(j)]); sum += c; cnt += (c > 0u) ? 1u : 0u; mine = (j == x) ? c : mine; }
        if (sum == G) break;
        __builtin_amdgcn_s_sleep(1);
        if ((++sp & 255u) == 0u) { if (xb_ld(&bar[XB_TMO])) break; if (sp > XB_SPIN_CAP) { atomicAdd(&bar[XB_TMO], 1u); break; } }
    }
    nloc = mine > 0u ? mine : 1u; nx = cnt > 0u ? cnt : 1u;
}
__device__ __forceinline__ void seam_convert(LAS unsigned char* lds, const Args& a, int batch) {
    const int tid = threadIdx.x, wave = __builtin_amdgcn_readfirstlane(tid >> 6), lane = tid & 63;
    if (wave >= 1 && wave <= 4) {
        LAS float* scr = (LAS float*)(lds + wave * 16640);
        const int base = (batch & 3) * 1024;
        for (int it = base + (int)blockIdx.x * 4 + (wave - 1); it < base + 1024; it += (int)gridDim.x * 4) {
            if (batch < 4) p0_transpose_item(a.mlp_w1 + (size_t)DM * FF, a.norm_mlp + DM, DM, FF, (bf16_t*)(a.ws + WS_WT_W1_1), scr, it, lane);
            else p0_transpose_item(a.mlp_w2 + (size_t)DM * FF, nullptr, FF, DM, (bf16_t*)(a.ws + WS_WT_W2_1), scr, it, lane);
        }
    }
}
__device__ __forceinline__ void seam_warm(LAS unsigned char* lds, const bf16_t* p, int wave_lo, const bool skip_last_quarter, const int nchunks) {
    const int tid = threadIdx.x, wave = __builtin_amdgcn_readfirstlane(tid >> 6), lane = tid & 63;
    if (wave >= wave_lo) {
        const int nw = 8 - wave_lo;
        const char* base = (const char*)p + lane * 16;
        for (int i = (int)blockIdx.x * nw + (wave - wave_lo); i < nchunks; i += (int)gridDim.x * nw)
            if (!(skip_last_quarter && (i & 15) >= 12)) __builtin_amdgcn_global_load_lds((const unsigned*)(base + (size_t)i * 1024), (LAS unsigned*)(lds + 98304 + wave * 1024), 16, 0, 0);
        asm volatile("s_waitcnt vmcnt(0)" ::: "memory");
    }
}
template <bool CONV>
__device__ __forceinline__ void xcd_barrier_t(const XcdBarrier& b, LAS unsigned char* lds, const Args& a, int batch, const bf16_t* warm = nullptr, int warm_lo = 8, const bool warm_skipq = false, const int warm_chunks = 32768) {
    asm volatile("s_waitcnt vmcnt(0)" ::: "memory");
    __syncthreads();
    if (threadIdx.x == 0) {
        unsigned* bar = b.bar;
        __builtin_amdgcn_s_waitcnt(0);
        unsigned nloc = b.st[0], nx = b.st[1];
        if (nloc == 0u) { xcd_barrier_complete(bar, b.x, nloc, nx); b.st[0] = nloc; b.st[1] = nx; }
        const unsigned old = xb_add(&bar[XB_XSUB(b.x)], 1u);
        const unsigned gen = old / nloc;
        if (old + 1u == (gen + 1u) * nloc) {
            __builtin_amdgcn_fence(__ATOMIC_RELEASE, "agent");
            asm volatile("s_waitcnt vmcnt(0)" ::: "memory");
            const unsigned og = xb_add(&bar[XB_TOP], 1u);
            const unsigned tg = og / nx;
            if (og + 1u == (tg + 1u) * nx) xb_add(&bar[XB_TOPGEN], 1u);
            else XB_SPIN(xb_ld(&bar[XB_TOPGEN]) == tg, bar);
            __builtin_amdgcn_fence(__ATOMIC_ACQUIRE, "agent");
            asm volatile("s_waitcnt vmcnt(0)" ::: "memory");
        } else {
            XB_SPIN(xb_ld(&bar[XB_TOPGEN]) == gen, bar);
            __builtin_amdgcn_fence(__ATOMIC_ACQUIRE, "agent");
            asm volatile("s_waitcnt vmcnt(0)" ::: "memory");
        }
    }
    if constexpr (CONV) seam_convert(lds, a, batch);
    if (warm) seam_warm(lds, warm, warm_lo, warm_skipq, warm_chunks);
    __syncthreads();
}
__device__ __forceinline__ void xcd_barrier(const XcdBarrier& b, LAS unsigned char* lds, const Args& a) { xcd_barrier_t<false>(b, lds, a, -1); }

__device__ __forceinline__ void jit_convert(LAS unsigned char* lds, const float* W, const float* sc, int K, int N, bf16_t* WT) {
    const int tid = threadIdx.x, wave = __builtin_amdgcn_readfirstlane(tid >> 6), lane = tid & 63;
    LAS float* scr = (LAS float*)(lds + wave * 16640);
    for (int it = (int)blockIdx.x * 8 + wave; it < 4096; it += (int)gridDim.x * 8) p0_transpose_item(W, sc, K, N, WT, scr, it, lane);
}

__global__ void __launch_bounds__(512, 2) mega_fwd(Args a) {
    extern __shared__ __attribute__((aligned(16))) unsigned char lds_raw[];
    LAS unsigned char* lds = (LAS unsigned char*)lds_raw;
    cg::grid_group grid = cg::this_grid();
    unsigned char* ws = a.ws;
    const int lo = a.ph_lo, hi = a.ph_hi;
#define IN(k) (lo <= (k) && (k) < hi)
    const bool multi = (hi - lo) > 1, use_cg = hi > 64;
    volatile LAS unsigned* xst = (volatile LAS unsigned*)(lds + XB_ST_OFF);
    if (threadIdx.x < 2) xst[threadIdx.x] = 0u;
    __syncthreads();
    XcdBarrier bar; bar.bar = (unsigned*)(ws + WS_BAR); bar.x = 0; bar.st = xst;
    if (multi && !use_cg) bar = xcd_barrier_post((unsigned*)(ws + WS_BAR), xst);
    const bool seamconv = multi && !use_cg && IN(0) && IN(11);
#define SEAM_BATCH(k) ((k) == 1 ? 0 : (k) == 2 ? 1 : (k) == 3 ? 2 : (k) == 4 ? 3 : (k) == 5 ? 4 : (k) == 6 ? 5 : (k) == 7 ? 6 : (k) == 9 ? 7 : -1)
#define SEAM(k) do { if (IN(k) && ((k) == 7 ? IN(9) : IN((k) + 1))) { if (use_cg) grid.sync(); else if (seamconv && SEAM_BATCH(k) >= 0) xcd_barrier_t<true>(bar, lds, a, SEAM_BATCH(k)); else xcd_barrier(bar, lds, a); } } while (0)
    bf16_t* HB = (bf16_t*)(ws + WS_HB); bf16_t* ACT = (bf16_t*)(ws + WS_ACT);
    if (IN(0)) p0_phase(lds, a, seamconv);
#if DUP_PHASE == 0
    if (IN(0)) p0_phase(lds, a, seamconv);
#endif
    if (seamconv) xcd_barrier_t<true>(bar, lds, a, 7);
    else SEAM(0);
    if (IN(1)) { Epi E{0, ACT, 4096, nullptr, nullptr, (float*)(ws + WS_VST), (const float*)(ws + WS_XST)};
        gemm_phase<0, 4096, 2048, 2048, false>(lds, HB, (const bf16_t*)(ws + WS_WT_AIN), E, (int)gridDim.x, (int)blockIdx.x); }
#if DUP_PHASE == 1
    if (IN(1)) { Epi E{0, ACT, 4096, nullptr, nullptr, (float*)(ws + WS_VST), (const float*)(ws + WS_XST)};
        gemm_phase<0, 4096, 2048, 2048, false>(lds, HB, (const bf16_t*)(ws + WS_WT_AIN), E, (int)gridDim.x, (int)blockIdx.x); }
#endif
    SEAM(1);
    if (IN(2)) spatial_phase(lds, a, (int)blockIdx.x, (int)gridDim.x);
    if (seamconv) { if (IN(2) && IN(3)) xcd_barrier_t<true>(bar, lds, a, SEAM_BATCH(2), (const bf16_t*)(ws + WS_WT_AOUT), 5, false, 8192); }
    else SEAM(2);
    if (IN(3)) { Epi E{6, HB, DM, nullptr, nullptr, (float*)(ws + WS_HST1), nullptr, nullptr, nullptr, HB};
        gemm_phase<6, 2048, 2048, 2048, false>(lds, ACT + (size_t)MTOK * 4096, (const bf16_t*)(ws + WS_WT_AOUT), E, (int)gridDim.x, (int)blockIdx.x); }
    if (seamconv) jit_convert(lds, a.mlp_w1, a.norm_mlp, DM, FF, (bf16_t*)(ws + WS_WT_W1_0));
    SEAM(3);
    if (IN(4)) { Epi E{2, ACT, FF, nullptr, nullptr, nullptr, (const float*)(ws + WS_HST1)};
        gemm_phase<2, 8192, 2048, 2048, false>(lds, HB, (const bf16_t*)(ws + WS_WT_W1_0), E, (int)gridDim.x, (int)blockIdx.x); }
#if DUP_PHASE == 4
    if (IN(4)) { Epi E{2, ACT, FF, nullptr, nullptr, nullptr, (const float*)(ws + WS_HST1)};
        gemm_phase<2, 8192, 2048, 2048, false>(lds, HB, (const bf16_t*)(ws + WS_WT_W1_0), E, (int)gridDim.x, (int)blockIdx.x); }
#endif
    if (seamconv) jit_convert(lds, a.mlp_w2, nullptr, FF, DM, (bf16_t*)(ws + WS_WT_W2_0));
    SEAM(4);
    if (IN(5)) { Epi E{6, HB, DM, nullptr, nullptr, (float*)(ws + WS_HST2), nullptr, nullptr, nullptr, HB};
        gemm_phase<6, 2048, 8192, 8192, false>(lds, ACT, (const bf16_t*)(ws + WS_WT_W2_0), E, (int)gridDim.x, (int)blockIdx.x); }
    if (seamconv) { if (IN(5) && IN(6)) xcd_barrier_t<true>(bar, lds, a, SEAM_BATCH(5), (const bf16_t*)(ws + WS_WT_BIN), 5, false, 8192); }
    else SEAM(5);
    if (IN(6)) { Epi E{3, ACT, DM, nullptr, nullptr, nullptr, (const float*)(ws + WS_HST2)};
        gemm_phase<3, 2048, 2048, 2048, false>(lds, HB, (const bf16_t*)(ws + WS_WT_BIN), E, (int)gridDim.x, (int)blockIdx.x); }
#if DUP_PHASE == 6
    if (IN(6)) { Epi E{3, ACT, DM, nullptr, nullptr, nullptr, (const float*)(ws + WS_HST2)};
        gemm_phase<3, 2048, 2048, 2048, false>(lds, HB, (const bf16_t*)(ws + WS_WT_BIN), E, (int)gridDim.x, (int)blockIdx.x); }
#endif
    SEAM(6);
    if (IN(7)) {
        const bool split = gridDim.x >= 128;
        const int gwc = split ? 64 : (int)gridDim.x;
        if ((int)blockIdx.x < gwc) { Epi E{4, (bf16_t*)(ws + WS_WCT), DM, nullptr, nullptr, nullptr, nullptr};
            gemm_phase<4, 2048, 512, 2048, true, 2048>(lds, (const bf16_t*)(ws + WS_WT_BOUT), (const bf16_t*)(ws + WS_WT_GRP), E, gwc, (int)blockIdx.x); }
        if (split) { if (blockIdx.x >= 64) pool_phase(a, (int)blockIdx.x - 64, (int)gridDim.x - 64); }
        else pool_phase(a, (int)blockIdx.x, (int)gridDim.x);
    }
    SEAM(7);
    if (IN(9)) { Epi E{6, HB, DM, nullptr, nullptr, (float*)(ws + WS_HST3), nullptr, nullptr, nullptr, HB};
        gemm_phase<6, 2048, 2048, 2048, false>(lds, ACT + (size_t)MTOK * DM, (const bf16_t*)(ws + WS_WCT), E, (int)gridDim.x, (int)blockIdx.x); }
    if (seamconv) { if (IN(9) && IN(10)) xcd_barrier_t<false>(bar, lds, a, -1, (const bf16_t*)(ws + WS_WT_W1_1), 1); }
    else SEAM(9);
    if (IN(10)) { Epi E{2, ACT, FF, nullptr, nullptr, nullptr, (const float*)(ws + WS_HST3)};
        gemm_phase<2, 8192, 2048, 2048, false>(lds, HB, (const bf16_t*)(ws + WS_WT_W1_1), E, (int)gridDim.x, (int)blockIdx.x); }
    if (seamconv) { if (IN(10) && IN(11)) xcd_barrier_t<false>(bar, lds, a, -1, (const bf16_t*)(ws + WS_WT_W2_1), 1); }
    else SEAM(10);
#if FUSE_FINAL
    if (IN(11)) { Epi E{5, nullptr, DM, a.out, nullptr, (float*)(ws + WS_HST4), nullptr, (unsigned*)(ws + WS_BAR + 16384), a.final_norm, HB};
        gemm_phase<5, 2048, 8192, 8192, false>(lds, ACT, (const bf16_t*)(ws + WS_WT_W2_1), E, (int)gridDim.x, (int)blockIdx.x); }
#else
    if (IN(11)) { Epi E{1, nullptr, DM, a.out, a.out, (float*)(ws + WS_HST4), nullptr};
        gemm_phase<1, 2048, 8192, 8192, false>(lds, ACT, (const bf16_t*)(ws + WS_WT_W2_1), E, (int)gridDim.x, (int)blockIdx.x); }
    SEAM(11);
    if (IN(12)) final_phase(a);
#endif
#undef IN
#undef SEAM
}

extern "C" void kernel_launch(void* const* d_in, const int* in_sizes, int n_in, void* d_out, int out_size, void* d_ws, size_t ws_size, hipStream_t stream) {
    static int grid = 0;
    if (grid == 0) {
        if (n_in != 16 || out_size != MTOK * DM || ws_size < WS_END) { fprintf(stderr, "kernel_launch: unexpected shapes (n_in %d out %d ws %zu need %zu)\n", n_in, out_size, ws_size, (size_t)WS_END); grid = -1; return; }
        int dev = 0, cus = 0, per_cu = 0;
        hipGetDevice(&dev);
        hipDeviceGetAttribute(&cus, hipDeviceAttributeMultiprocessorCount, dev);
        hipFuncSetAttribute((const void*)mega_fwd, hipFuncAttributeMaxDynamicSharedMemorySize, LDS_BYTES);
        hipOccupancyMaxActiveBlocksPerMultiprocessor(&per_cu, (const void*)mega_fwd, 512, LDS_BYTES);
        if (per_cu < 1) { fprintf(stderr, "kernel_launch: occupancy query reports %d blocks per CU\n", per_cu); per_cu = 1; }
        (void)hipGetLastError();
        grid = cus * 1;
    }
    if (grid < 0) return;
    Args a{};
    a.x = (const float*)d_in[0]; a.a_w_in = (const float*)d_in[1]; a.a_ln_g = (const float*)d_in[2]; a.a_ln_b = (const float*)d_in[3]; a.a_w_s = (const float*)d_in[4];
    a.a_b_s = (const float*)d_in[5]; a.a_w_out = (const float*)d_in[6]; a.b_w_in = (const float*)d_in[7]; a.b_w_grp = (const float*)d_in[8]; a.b_scale = (const float*)d_in[9];
    a.b_w_out = (const float*)d_in[10]; a.norm_mix = (const float*)d_in[11]; a.norm_mlp = (const float*)d_in[12]; a.mlp_w1 = (const float*)d_in[13]; a.mlp_w2 = (const float*)d_in[14];
    a.final_norm = (const float*)d_in[15]; a.out = (float*)d_out; a.ws = (unsigned char*)d_ws;
#if N_LAUNCH_MODE == 1
    a.ph_lo = 0; a.ph_hi = 13;
    if (hipMemsetAsync((unsigned char*)d_ws + WS_BAR, 0, 32768, stream) != hipSuccess) { fprintf(stderr, "kernel_launch: memset of the barrier words failed\n"); return; }
    void* args[] = {&a};
    hipError_t e = hipLaunchCooperativeKernel((const void*)mega_fwd, dim3(grid), dim3(512), args, LDS_BYTES, stream);
    if (e != hipSuccess) fprintf(stderr, "cooperative launch failed: %s (grid %d)\n", hipGetErrorString(e), grid);
#else
    for (int ph = 0; ph < 13; ++ph) { a.ph_lo = ph; a.ph_hi = ph + 1; hipLaunchKernelGGL(mega_fwd, dim3(grid), dim3(512), LDS_BYTES, stream, a); }
#endif
}
```
